# Optimizing an MI355X kernel written in HIP

```python
import math
import jax, jax.numpy as jnp
from jax import lax
import numpy as np

D_MODEL = 2048
BATCH = 2
SEQ = 4096
DEPTH = 1

MEM_LEN = 256
HEAD_DIM = 128
DIFF_HEADS = 8
DIFF_HALF = HEAD_DIM // 2
DIFF_WIDTH = DIFF_HEADS * HEAD_DIM
MOBA_HEADS = 8
MOBA_WIDTH = MOBA_HEADS * HEAD_DIM
D_MIX = DIFF_WIDTH + MOBA_WIDTH
IN_COLS = 3 * DIFF_WIDTH + 3 * MOBA_WIDTH + D_MIX
MOBA_BLOCK = 256
MOBA_TOPK = 3
MOBA_Q_CHUNK = 32
DENSE_Q_BLOCK = 128
MEM_HEADS = 4
MEM_WIDTH = MEM_HEADS * HEAD_DIM
EPS = 1e-6
SPLITS = [DIFF_WIDTH, 2 * DIFF_WIDTH, 3 * DIFF_WIDTH,
          3 * DIFF_WIDTH + MOBA_WIDTH, 3 * DIFF_WIDTH + 2 * MOBA_WIDTH,
          3 * DIFF_WIDTH + 3 * MOBA_WIDTH]

kernel_name = "hybrid_diffattn_moba_gated_memxattn"


def rmsnorm(x, g):
    xf = x.astype(jnp.float32)
    r = lax.rsqrt(jnp.mean(xf * xf, axis=-1, keepdims=True) + EPS)
    return (xf * r).astype(x.dtype) * g


def alibi_slopes(n):
    return jnp.asarray(2.0 ** (-8.0 * np.arange(1, n + 1) / n), dtype=jnp.float32)


def diff_attention(q, k, v, lam, subln_g, lam_init, slopes):
    B, H, S = q.shape[:3]
    nqb = S // DENSE_Q_BLOCK
    scale = DIFF_HALF ** -0.5
    kpos = jnp.arange(S)
    qb = q.reshape(B, H, nqb, DENSE_Q_BLOCK, 2, DIFF_HALF).transpose(2, 0, 1, 3, 4, 5)

    def one_block(args):
        i, qi = args
        qpos = i * DENSE_Q_BLOCK + jnp.arange(DENSE_Q_BLOCK)
        dist = (qpos[:, None] - kpos[None, :]).astype(jnp.float32)
        bias = -slopes[:, None, None] * dist
        logits = jnp.einsum('bhqcd,bhkcd->bhcqk', qi, k).astype(jnp.float32) * scale
        logits = jnp.where(dist >= 0, logits + bias[None, :, None], -jnp.inf)
        p = jax.nn.softmax(logits, axis=-1)
        attn = p[:, :, 0] - lam.astype(jnp.float32) * p[:, :, 1]
        return jnp.einsum('bhqk,bhkd->bhqd', attn.astype(v.dtype), v)

    o = lax.map(one_block, (jnp.arange(nqb), qb))
    o = o.transpose(1, 2, 0, 3, 4).reshape(B, H, S, HEAD_DIM)
    return rmsnorm(o, subln_g) * (1.0 - lam_init)


def moba_attention(q, k, v, slopes):
    B, H, S, D = q.shape
    nb = -(-S // MOBA_BLOCK)
    pad = nb * MOBA_BLOCK - S
    scale = D ** -0.5
    tk = min(MOBA_TOPK, nb)
    kpad = jnp.pad(k, ((0, 0), (0, 0), (0, pad), (0, 0)))
    vpad = jnp.pad(v, ((0, 0), (0, 0), (0, pad), (0, 0)))
    kb = kpad.reshape(B, H, nb, MOBA_BLOCK, D)
    vb = vpad.reshape(B, H, nb, MOBA_BLOCK, D)
    kmean = jnp.mean(kb.astype(jnp.float32), axis=3)
    nqc = S // MOBA_Q_CHUNK
    qc = q.reshape(B, H, nqc, MOBA_Q_CHUNK, D).transpose(2, 0, 1, 3, 4)
    bi = jnp.arange(B)[:, None, None, None]
    hi = jnp.arange(H)[None, :, None, None]
    blk = jnp.arange(MOBA_BLOCK)

    def one_chunk(args):
        i, qi = args
        start = i * MOBA_Q_CHUNK
        cur = start // MOBA_BLOCK
        qpos = start + jnp.arange(MOBA_Q_CHUNK)
        gate = jnp.einsum('bhqd,bhnd->bhqn', qi.astype(jnp.float32), kmean)
        gate = jnp.where(jnp.arange(nb) < cur, gate, -jnp.inf)
        _, idx = lax.top_k(gate, tk)
        valid = idx < cur
        kg = kb[bi, hi, idx]
        vg = vb[bi, hi, idx]
        lg = jnp.einsum('bhqd,bhqjsd->bhqjs', qi, kg).astype(jnp.float32) * scale
        spos = idx[..., None] * MOBA_BLOCK + blk
        gdist = (qpos[None, None, :, None, None] - spos).astype(jnp.float32)
        lg = lg - slopes[None, :, None, None, None] * gdist
        lg = jnp.where(valid[..., None], lg, -jnp.inf).reshape(B, H, MOBA_Q_CHUNK, tk * MOBA_BLOCK)
        own_k = lax.dynamic_slice_in_dim(kpad, cur * MOBA_BLOCK, MOBA_BLOCK, axis=2)
        own_v = lax.dynamic_slice_in_dim(vpad, cur * MOBA_BLOCK, MOBA_BLOCK, axis=2)
        lo = jnp.einsum('bhqd,bhsd->bhqs', qi, own_k).astype(jnp.float32) * scale
        odist = (qpos[:, None] - (cur * MOBA_BLOCK + blk)[None, :]).astype(jnp.float32)
        lo = jnp.where(odist >= 0, lo - slopes[:, None, None] * odist, -jnp.inf)
        p = jax.nn.softmax(jnp.concatenate([lg, lo], axis=-1), axis=-1)
        pg = p[..., :tk * MOBA_BLOCK].reshape(B, H, MOBA_Q_CHUNK, tk, MOBA_BLOCK).astype(v.dtype)
        po = p[..., tk * MOBA_BLOCK:].astype(v.dtype)
        return (jnp.einsum('bhqjs,bhqjsd->bhqd', pg, vg)
                + jnp.einsum('bhqs,bhsd->bhqd', po, own_v))

    o = lax.map(one_chunk, (jnp.arange(nqc), qc))
    return o.transpose(1, 2, 0, 3, 4).reshape(B, H, S, D)


def setup_inputs(seed: int = 0) -> dict:
    key = jax.random.key(seed)
    ks = jax.random.split(key, 16)
    f32 = jnp.float32

    def w(k, shape, fan_in):
        return jax.random.normal(k, shape, f32) * fan_in ** -0.5

    def gain(k, shape):
        return 1.0 + 0.02 * jax.random.normal(k, shape, f32)

    return {
        "x": jax.random.normal(ks[0], (BATCH, SEQ, D_MODEL), f32),
        "mem": jax.random.normal(ks[1], (BATCH, MEM_LEN, D_MODEL), f32),
        "norm_mix_g": gain(ks[2], (DEPTH, D_MODEL)),
        "w_in": w(ks[3], (DEPTH, D_MODEL, IN_COLS), D_MODEL),
        "lambda_q1": 0.1 * jax.random.normal(ks[4], (DEPTH, DIFF_HALF), f32),
        "lambda_k1": 0.1 * jax.random.normal(ks[5], (DEPTH, DIFF_HALF), f32),
        "lambda_q2": 0.1 * jax.random.normal(ks[6], (DEPTH, DIFF_HALF), f32),
        "lambda_k2": 0.1 * jax.random.normal(ks[7], (DEPTH, DIFF_HALF), f32),
        "subln_g": gain(ks[8], (DEPTH, HEAD_DIM)),
        "w_out": w(ks[9], (DEPTH, D_MIX, D_MODEL), D_MIX),
        "norm_mem_g": gain(ks[10], (DEPTH, D_MODEL)),
        "mem_norm_g": gain(ks[11], (DEPTH, D_MODEL)),
        "w_q_mem": w(ks[12], (DEPTH, D_MODEL, MEM_WIDTH), D_MODEL),
        "w_kv_mem": w(ks[13], (DEPTH, D_MODEL, 2 * MEM_WIDTH), D_MODEL),
        "w_o_mem": w(ks[14], (DEPTH, MEM_WIDTH, D_MODEL), MEM_WIDTH),
        "final_g": gain(ks[15], (D_MODEL,)),
    }


def reference(x, mem, norm_mix_g, w_in, lambda_q1, lambda_k1, lambda_q2, lambda_k2,
              subln_g, w_out, norm_mem_g, mem_norm_g, w_q_mem, w_kv_mem, w_o_mem, final_g):
    B, S, _ = x.shape
    M = mem.shape[1]
    diff_slopes = alibi_slopes(DIFF_HEADS)
    moba_slopes = alibi_slopes(MOBA_HEADS)
    for l in range(DEPTH):
        h = rmsnorm(x, norm_mix_g[l])
        proj = jnp.einsum('bsd,de->bse', h, w_in[l])
        dq, dk, dv, mq, mk, mv, gate = jnp.split(proj, SPLITS, axis=-1)
        dq = dq.reshape(B, S, DIFF_HEADS, 2, DIFF_HALF).transpose(0, 2, 1, 3, 4)
        dk = dk.reshape(B, S, DIFF_HEADS, 2, DIFF_HALF).transpose(0, 2, 1, 3, 4)
        dv = dv.reshape(B, S, DIFF_HEADS, HEAD_DIM).transpose(0, 2, 1, 3)
        lam_init = 0.8 - 0.6 * math.exp(-0.3 * l)
        lam = (jnp.exp(jnp.sum(lambda_q1[l].astype(jnp.float32) * lambda_k1[l].astype(jnp.float32)))
               - jnp.exp(jnp.sum(lambda_q2[l].astype(jnp.float32) * lambda_k2[l].astype(jnp.float32)))
               + lam_init)
        d_out = diff_attention(dq, dk, dv, lam, subln_g[l], lam_init, diff_slopes)
        d_out = d_out.transpose(0, 2, 1, 3).reshape(B, S, DIFF_WIDTH)
        mq = mq.reshape(B, S, MOBA_HEADS, HEAD_DIM).transpose(0, 2, 1, 3)
        mk = mk.reshape(B, S, MOBA_HEADS, HEAD_DIM).transpose(0, 2, 1, 3)
        mv = mv.reshape(B, S, MOBA_HEADS, HEAD_DIM).transpose(0, 2, 1, 3)
        m_out = moba_attention(mq, mk, mv, moba_slopes)
        m_out = m_out.transpose(0, 2, 1, 3).reshape(B, S, MOBA_WIDTH)
        y = jnp.concatenate([d_out, m_out], axis=-1) * jax.nn.silu(gate)
        x = x + jnp.einsum('bse,ed->bsd', y, w_out[l])
        h2 = rmsnorm(x, norm_mem_g[l])
        mn = rmsnorm(mem, mem_norm_g[l])
        q = jnp.einsum('bsd,de->bse', h2, w_q_mem[l]).reshape(B, S, MEM_HEADS, HEAD_DIM)
        kv = jnp.einsum('bmd,de->bme', mn, w_kv_mem[l])
        km, vm = jnp.split(kv, 2, axis=-1)
        km = km.reshape(B, M, MEM_HEADS, HEAD_DIM)
        vm = vm.reshape(B, M, MEM_HEADS, HEAD_DIM)
        logits = jnp.einsum('bshd,bmhd->bhsm', q, km).astype(jnp.float32) * HEAD_DIM ** -0.5
        p = jax.nn.softmax(logits, axis=-1).astype(vm.dtype)
        o = jnp.einsum('bhsm,bmhd->bshd', p, vm).reshape(B, S, MEM_WIDTH)
        x = x + jnp.einsum('bse,ed->bsd', o, w_o_mem[l])
    return rmsnorm(x, final_g)
```

```cpp
#include <hip/hip_runtime.h>
#include <hip/hip_cooperative_groups.h>
#include <cstdio>
#include <cstdint>
namespace cg = cooperative_groups;

#ifndef MK_N_LAUNCHES
#define MK_N_LAUNCHES 1
#endif
namespace pg8 {
#define PG8_LAS __attribute__((address_space(3)))
typedef unsigned short bf16_t;
typedef short bf16x8 __attribute__((ext_vector_type(8)));
typedef float f32x4 __attribute__((ext_vector_type(4)));
typedef unsigned u32x4 __attribute__((ext_vector_type(4)));
constexpr int BM = 256, BK = 64, HALF = 128, HTB = HALF * BK * 2  , STAGE_BYTES = 8 * HTB, NXCD = 8, WGM = 8;

__host__ __device__ __forceinline__ int lds_byte(int r, int c) { const int st = (r >> 4) * 2 + (c >> 5), rr = r & 15, cc = c & 31, ob = rr * 64 + cc * 2; return st * 1024 + (ob ^ (((ob >> 9) & 1) << 5)); }
__host__ __device__ __forceinline__ void stage_rc(int b, int& R, int& C) { const int st = b / 1024, sb = b % 1024, swz = sb ^ (((sb >> 9) & 1) << 5); R = (st >> 1) * 16 + swz / 64; C = (st & 1) * 32 + (swz % 64) / 2; }
__host__ __device__ __forceinline__ int perm32(int rho) { const int n = rho >> 4, i = rho & 15; return 8 * (i >> 2) + 4 * n + (i & 3); }

struct Unit { int pm, pn; };
struct Gemm { const bf16_t* A; const bf16_t* Bt; int M, N, K; };

struct StaticOrder {
    int nM, nN, nwg, G, c;
    __host__ __device__ void init(int M, int N, int G_, int c_) { nM = M / BM; nN = N / BM; nwg = nM * nN; G = G_; c = c_; }
    __host__ __device__ bool next(int i, Unit& u) const {
        const long L = (long)i * G + c; if (L >= nwg) return false;
        int wgid = (int)L; { const int q = nwg / NXCD, r = nwg % NXCD, xcd = wgid % NXCD, off = wgid / NXCD; wgid = (xcd < r ? xcd * (q + 1) : r * (q + 1) + (xcd - r) * q) + off; }
        const int nig = WGM * nN, gid = wgid / nig, fm = gid * WGM, gsz = (nM - fm) < WGM ? (nM - fm) : WGM;
        u.pm = fm + ((wgid % nig) % gsz); u.pn = (wgid % nig) / gsz; return true;
    }
    __device__ __forceinline__ void a_ready(const Unit&) const {}
    __device__ __forceinline__ void done(const Unit&) const {}
};

__device__ __forceinline__ unsigned cvt_pk_bf16(float lo, float hi) { unsigned r; asm volatile("v_cvt_pk_bf16_f32 %0, %1, %2" : "=v"(r) : "v"(lo), "v"(hi)); return r; }
typedef float f32x2 __attribute__((ext_vector_type(2)));
struct EpiScaleBf16 {
    static constexpr bool PERM = true, AFTER_DRAIN = false;
    bf16_t* O; int ldc; int c0lo, c0hi; float s0; int c1lo, c1hi; float s1;
    __device__ __forceinline__ void operator()(const f32x4 (&acc)[2][2][4][2], const Unit& u, int wr, int wc, int fr, int fq) const {
        const int colt = u.pn * BM;
        const float sc = (colt >= c0lo && colt < c0hi) ? s0 : ((colt >= c1lo && colt < c1hi) ? s1 : 1.f);
        const int row0 = u.pm * BM + wr * 64 + fr, col0 = colt + wc * 32 + 8 * fq;
#pragma unroll
        for (int ai = 0; ai < 2; ++ai)
#pragma unroll
            for (int m = 0; m < 4; ++m) { bf16_t* rowp = O + (size_t)(row0 + ai * HALF + m * 16) * ldc + col0;
#pragma unroll
                for (int bj = 0; bj < 2; ++bj) { const f32x4 v0 = acc[ai][bj][m][0] * sc, v1 = acc[ai][bj][m][1] * sc;
                    u32x4 w; w.x = cvt_pk_bf16(v0[0], v0[1]); w.y = cvt_pk_bf16(v0[2], v0[3]); w.z = cvt_pk_bf16(v1[0], v1[1]); w.w = cvt_pk_bf16(v1[2], v1[3]);
                    *(u32x4*)(rowp + bj * HALF) = w; } }
    }
};
struct EpiResid {
    static constexpr bool PERM = true, AFTER_DRAIN = false;
    const float* base; float* out; bf16_t* outb; float* part; int ldc;
    __device__ __forceinline__ void operator()(const f32x4 (&acc)[2][2][4][2], const Unit& u, int wr, int wc, int fr, int fq) const {
        const int row0 = u.pm * BM + wr * 64 + fr, col0 = u.pn * BM + wc * 32 + 8 * fq;
#pragma unroll
        for (int ai = 0; ai < 2; ++ai)
#pragma unroll
            for (int m = 0; m < 4; ++m) { const int row = row0 + ai * HALF + m * 16; const size_t off = (size_t)row * ldc + col0; float ss = 0.f;
#pragma unroll
                for (int bj = 0; bj < 2; ++bj) {
                    const f32x4 b0 = *(const f32x4*)(base + off + bj * HALF), b1 = *(const f32x4*)(base + off + bj * HALF + 4);
                    const f32x4 v0 = acc[ai][bj][m][0] + b0, v1 = acc[ai][bj][m][1] + b1;
                    *(f32x4*)(out + off + bj * HALF) = v0; *(f32x4*)(out + off + bj * HALF + 4) = v1;
                    if (outb) { u32x4 w; w.x = cvt_pk_bf16(v0[0], v0[1]); w.y = cvt_pk_bf16(v0[2], v0[3]); w.z = cvt_pk_bf16(v1[0], v1[1]); w.w = cvt_pk_bf16(v1[2], v1[3]);
                        *(u32x4*)(outb + off + bj * HALF) = w; }
                    ss += (v0[0] * v0[0] + v0[1] * v0[1]) + (v0[2] * v0[2] + v0[3] * v0[3]) + (v1[0] * v1[0] + v1[1] * v1[1]) + (v1[2] * v1[2] + v1[3] * v1[3]); }
                ss += __shfl_xor(ss, 16); ss += __shfl_xor(ss, 32);
                if (fq == 0) part[(size_t)row * 32 + u.pn * 4 + wc] = ss; }
    }
};
struct EpiRowNormBf16 {
    static constexpr bool PERM = true, AFTER_DRAIN = false;
    bf16_t* O; int ldc; const float* part; float sc, inv_n, eps;
    __device__ __forceinline__ void operator()(const f32x4 (&acc)[2][2][4][2], const Unit& u, int wr, int wc, int fr, int fq) const {
        const int row0 = u.pm * BM + wr * 64 + fr, col0 = u.pn * BM + wc * 32 + 8 * fq;
#pragma unroll
        for (int ai = 0; ai < 2; ++ai)
#pragma unroll
            for (int m = 0; m < 4; ++m) { const int row = row0 + ai * HALF + m * 16; const f32x4* pp = (const f32x4*)(part + (size_t)row * 32);
                f32x4 s4 = pp[0];
#pragma unroll
                for (int j = 1; j < 8; ++j) s4 = s4 + pp[j];
                const float r = sc / sqrtf(((s4[0] + s4[1]) + (s4[2] + s4[3])) * inv_n + eps);
                bf16_t* rowp = O + (size_t)row * ldc + col0;
#pragma unroll
                for (int bj = 0; bj < 2; ++bj) { const f32x4 v0 = acc[ai][bj][m][0] * r, v1 = acc[ai][bj][m][1] * r;
                    u32x4 w; w.x = cvt_pk_bf16(v0[0], v0[1]); w.y = cvt_pk_bf16(v0[2], v0[3]); w.z = cvt_pk_bf16(v1[0], v1[1]); w.w = cvt_pk_bf16(v1[2], v1[3]);
                    *(u32x4*)(rowp + bj * HALF) = w; } }
    }
};

template <class Epi, class Sched, bool ALIGN_EPI = false, bool SP2 = false>
__device__ __forceinline__ void gemm_phase(PG8_LAS unsigned char* lds, const Gemm g, const Sched& S, const Epi& E, const int wid) {
    unsigned z_ = 0u; asm volatile("" : "+v"(z_)); const int lane = (int)__builtin_amdgcn_mbcnt_hi(~0u, __builtin_amdgcn_mbcnt_lo(~0u, z_)), tid = wid * 64 + lane, wr = wid >> 2, wc = wid & 3, fr = lane & 15, fq = lane >> 4;
    const int K = g.K, nt = K / BK;
    unsigned voffA[2], voffB[2];
#pragma unroll
    for (int i = 0; i < 2; ++i) { int R, C; stage_rc(tid * 16 + i * 8192, R, C); const int Rb = Epi::PERM ? ((R & ~31) + perm32(R & 31)) : R;
        voffA[i] = (unsigned)(R * K + C) * 2u; voffB[i] = (unsigned)(Rb * K + C) * 2u; }
    const size_t kstep = (size_t)(BK * 2);
    const size_t hstep = (size_t)HALF * K * 2;
    const size_t tstep = 2 * hstep;
    const unsigned ldsw = (unsigned)wid * 1024u;
    const int aoff = lds_byte(wr * 64 + fr, fq * 8), boff = lds_byte(wc * 32 + fr, fq * 8);
#define PG8_SA(b, h) (((b) * 2 + (h)) * HTB)
#define PG8_SB(b, h) ((4 + (b) * 2 + (h)) * HTB)
#define PG8_STAGE(bufoff, gbase, voff) do { _Pragma("unroll") for (int _i = 0; _i < 2; ++_i) \
        __builtin_amdgcn_global_load_lds((const unsigned*)((const char*)(gbase) + (voff)[_i]), (PG8_LAS unsigned*)(lds + (bufoff) + ldsw + _i * 8192), 16, 0, 0); } while (0)
#define PG8_LDA(dst, b, h) do { _Pragma("unroll") for (int m = 0; m < 4; ++m) _Pragma("unroll") for (int k = 0; k < 2; ++k) dst[m][k] = *(const PG8_LAS bf16x8*)(lds + PG8_SA(b, h) + aoff + m * 2048 + k * 1024); } while (0)
#define PG8_LDB(dst, b, h) do { _Pragma("unroll") for (int n = 0; n < 2; ++n) _Pragma("unroll") for (int k = 0; k < 2; ++k) dst[n][k] = *(const PG8_LAS bf16x8*)(lds + PG8_SB(b, h) + boff + n * 2048 + k * 1024); } while (0)
#define PG8_MMA(ai, bj, At, Bt) do { __builtin_amdgcn_s_setprio(1); _Pragma("unroll") for (int m = 0; m < 4; ++m) _Pragma("unroll") for (int n = 0; n < 2; ++n) _Pragma("unroll") for (int k = 0; k < 2; ++k) \
        acc[ai][bj][m][n] = __builtin_amdgcn_mfma_f32_16x16x32_bf16(Bt[n][k], At[m][k], acc[ai][bj][m][n], 0, 0, 0); __builtin_amdgcn_s_setprio(0); } while (0)
#define PG8_WAIT_V(n) asm volatile("s_waitcnt vmcnt(" #n ")" ::: "memory")
#define PG8_WAIT_L(n) asm volatile("s_waitcnt lgkmcnt(" #n ")" ::: "memory")
#define PG8_BAR __builtin_amdgcn_s_barrier()
#define PG8_SCHED __builtin_amdgcn_sched_barrier(0)
    Unit cur, nxt; int ui = 0;
    if (!S.next(0, cur)) return;
    f32x4 acc[2][2][4][2];
#pragma unroll
    for (int a = 0; a < 2; ++a)
#pragma unroll
        for (int b = 0; b < 2; ++b)
#pragma unroll
            for (int m = 0; m < 4; ++m)
#pragma unroll
                for (int n = 0; n < 2; ++n) acc[a][b][m][n] = (f32x4){0.f, 0.f, 0.f, 0.f};
    bf16x8 At[4][2], B0[2][2], B1[2][2];
    const char* cA = (const char*)g.A + (size_t)cur.pm * tstep; const char* cB = (const char*)g.Bt + (size_t)cur.pn * tstep;
    S.a_ready(cur);
    if constexpr (SP2) {
        PG8_STAGE(PG8_SB(0, 0), cB, voffB); PG8_STAGE(PG8_SB(0, 1), cB + hstep, voffB); PG8_STAGE(PG8_SA(0, 0), cA, voffA); PG8_STAGE(PG8_SA(0, 1), cA + hstep, voffA);
        if (wr == 1) PG8_BAR;
        PG8_WAIT_V(2); PG8_BAR;
        PG8_STAGE(PG8_SB(1, 0), cB + kstep, voffB); PG8_STAGE(PG8_SA(1, 0), cA + kstep, voffA); PG8_STAGE(PG8_SB(1, 1), cB + hstep + kstep, voffB);
        PG8_WAIT_V(6); PG8_BAR;
    } else {
        PG8_STAGE(PG8_SB(0, 0), cB, voffB); PG8_STAGE(PG8_SA(0, 0), cA, voffA); PG8_STAGE(PG8_SB(0, 1), cB + hstep, voffB); PG8_STAGE(PG8_SA(0, 1), cA + hstep, voffA);
        if (wr == 1) PG8_BAR;
        PG8_WAIT_V(4); PG8_BAR;
        PG8_STAGE(PG8_SB(1, 0), cB + kstep, voffB); PG8_STAGE(PG8_SA(1, 0), cA + kstep, voffA); PG8_STAGE(PG8_SB(1, 1), cB + hstep + kstep, voffB);
        PG8_WAIT_V(6); PG8_BAR;
    }
    for (;;) {
        const bool has_next = S.next(ui + 1, nxt);
        const char* nA = has_next ? (const char*)g.A + (size_t)nxt.pm * tstep : cA; const char* nB = has_next ? (const char*)g.Bt + (size_t)nxt.pn * tstep : cB;
        for (int t = 0; t < nt; t += 2) {
            const bool last = (t == nt - 2);
            const char* a1 = cA + (size_t)(t + 1) * kstep;
            const char* a2 = last ? nA : cA + (size_t)(t + 2) * kstep; const char* b2 = last ? nB : cB + (size_t)(t + 2) * kstep;
            const char* a3 = a2 + kstep; const char* b3 = b2 + kstep;
            if (last && has_next) S.a_ready(nxt);
            if constexpr (SP2) {
            PG8_LDB(B0, 0, 0); PG8_LDB(B1, 0, 1); PG8_SCHED; PG8_LDA(At, 0, 0); PG8_STAGE(PG8_SA(1, 1), a1 + hstep, voffA);
            PG8_WAIT_V(8); PG8_WAIT_L(0); PG8_BAR; PG8_MMA(0, 0, At, B0); PG8_MMA(0, 1, At, B1); PG8_BAR; PG8_SCHED;
            PG8_LDA(At, 0, 1); PG8_STAGE(PG8_SB(0, 0), b2, voffB); PG8_STAGE(PG8_SB(0, 1), b2 + hstep, voffB); PG8_STAGE(PG8_SA(0, 0), a2, voffA);
            PG8_WAIT_V(8); PG8_WAIT_L(0); PG8_BAR; PG8_MMA(1, 0, At, B0); PG8_MMA(1, 1, At, B1); PG8_BAR; PG8_SCHED;
            PG8_LDB(B0, 1, 0); PG8_LDB(B1, 1, 1); PG8_SCHED; PG8_LDA(At, 1, 0); PG8_STAGE(PG8_SA(0, 1), a2 + hstep, voffA);
            PG8_WAIT_V(8); PG8_WAIT_L(0); PG8_BAR; PG8_MMA(0, 0, At, B0); PG8_MMA(0, 1, At, B1); PG8_BAR; PG8_SCHED;
            PG8_LDA(At, 1, 1); PG8_STAGE(PG8_SB(1, 0), b3, voffB); PG8_STAGE(PG8_SB(1, 1), b3 + hstep, voffB); PG8_STAGE(PG8_SA(1, 0), a3, voffA);
            PG8_WAIT_V(8); PG8_WAIT_L(0); PG8_BAR; PG8_MMA(1, 0, At, B0); PG8_MMA(1, 1, At, B1); PG8_BAR; PG8_SCHED;
            } else {
            PG8_LDB(B0, 0, 0); PG8_SCHED; PG8_LDA(At, 0, 0); PG8_STAGE(PG8_SA(1, 1), a1 + hstep, voffA);
            PG8_WAIT_L(8); PG8_BAR; PG8_WAIT_L(0); PG8_MMA(0, 0, At, B0); PG8_BAR; PG8_SCHED;
            PG8_LDB(B1, 0, 1); PG8_STAGE(PG8_SB(0, 0), b2, voffB);
            PG8_BAR; PG8_WAIT_L(0); PG8_MMA(0, 1, At, B1); PG8_BAR;
            PG8_LDA(At, 0, 1); PG8_STAGE(PG8_SA(0, 0), a2, voffA);
            PG8_BAR; PG8_WAIT_L(0); PG8_MMA(1, 0, At, B0); PG8_BAR; PG8_SCHED;
            PG8_STAGE(PG8_SB(0, 1), b2 + hstep, voffB);
            PG8_WAIT_V(6); PG8_BAR; PG8_MMA(1, 1, At, B1); PG8_BAR;
            PG8_LDB(B0, 1, 0); PG8_SCHED; PG8_LDA(At, 1, 0); PG8_STAGE(PG8_SA(0, 1), a2 + hstep, voffA);
            PG8_WAIT_L(8); PG8_BAR; PG8_WAIT_L(0); PG8_MMA(0, 0, At, B0); PG8_BAR; PG8_SCHED;
            PG8_LDB(B1, 1, 1); PG8_STAGE(PG8_SB(1, 0), b3, voffB);
            PG8_BAR; PG8_WAIT_L(0); PG8_MMA(0, 1, At, B1); PG8_BAR;
            PG8_LDA(At, 1, 1); PG8_STAGE(PG8_SA(1, 0), a3, voffA);
            PG8_BAR; PG8_WAIT_L(0); PG8_MMA(1, 0, At, B0); PG8_BAR; PG8_SCHED;
            PG8_STAGE(PG8_SB(1, 1), b3 + hstep, voffB);
            PG8_WAIT_V(6); PG8_BAR; PG8_MMA(1, 1, At, B1); PG8_BAR;
            }
        }
        if constexpr (ALIGN_EPI) { if (wr == 0) PG8_BAR; }
        if constexpr (!Epi::AFTER_DRAIN) { E(acc, cur, wr, wc, fr, fq); S.done(cur); }
        if (!has_next) break;
#pragma unroll
        for (int a = 0; a < 2; ++a)
#pragma unroll
            for (int b = 0; b < 2; ++b)
#pragma unroll
                for (int m = 0; m < 4; ++m)
#pragma unroll
                    for (int n = 0; n < 2; ++n) acc[a][b][m][n] = (f32x4){0.f, 0.f, 0.f, 0.f};
        cur = nxt; cA = nA; cB = nB; ++ui;
        if constexpr (ALIGN_EPI) { if (wr == 1) PG8_BAR; }
    }
    PG8_WAIT_V(0);
    if constexpr (!ALIGN_EPI) { if (wr == 0) PG8_BAR; }
    PG8_BAR;
    if constexpr (Epi::AFTER_DRAIN) { E.fused(acc, cur, wr, wc, fr, fq, lds, wid, lane); S.done(cur); }
#undef PG8_SA
#undef PG8_SB
#undef PG8_STAGE
#undef PG8_LDA
#undef PG8_LDB
#undef PG8_MMA
#undef PG8_WAIT_V
#undef PG8_WAIT_L
#undef PG8_BAR
#undef PG8_SCHED
}
}

#ifndef KVGPR
#define KVGPR
#endif
constexpr int NWAVES = 8;
constexpr int N_LAUNCHES = MK_N_LAUNCHES;
constexpr int N_PHASES = 9;
constexpr int BATCH = 2, SEQ = 4096, DM = 2048, MROWS = BATCH * SEQ;
constexpr int MEMLEN = 256, MEMROWS = BATCH * MEMLEN;
constexpr int NQKG = 6144;
constexpr int NVT = 2048;
constexpr int MEMW = 512;
constexpr float EPS = 1e-6f;
constexpr float LOG2E = 1.4426950408889634f;
constexpr size_t MiB = 1u << 20;
constexpr size_t WS_CTL = 0, CTL_ZERO_BYTES = 64 * 1024;
constexpr size_t WS_WTIN = 1 * MiB;
constexpr size_t WS_WTOUT = 33 * MiB;
constexpr size_t WS_WTQ = 41 * MiB;
constexpr size_t WS_WTKV = 43 * MiB;
constexpr size_t WS_WTO = 47 * MiB;
constexpr size_t WS_XB = 49 * MiB;
constexpr size_t WS_MEMB = 81 * MiB;
constexpr size_t WS_KMEAN = 83 * MiB;
constexpr size_t WS_PART1 = 84 * MiB;
constexpr size_t WS_PART2 = 85 * MiB;
constexpr size_t WS_QKG = 86 * MiB;
constexpr size_t WS_VT = 182 * MiB;
constexpr size_t WS_Y = 214 * MiB;
constexpr size_t WS_X1 = 86 * MiB;
constexpr size_t WS_X1B = 150 * MiB;
constexpr size_t WS_QM = 182 * MiB;
constexpr size_t WS_KMEM = 190 * MiB;
constexpr size_t WS_VMEMT = 191 * MiB;
constexpr size_t WS_OM = 192 * MiB;
constexpr size_t WS_END = 256 * MiB;
constexpr int CW_QUEUE = 16;
constexpr int LDS_BYTES = 147456;
constexpr int XCH_OFF = 65536;
constexpr int MISC_OFF = 131072;

#define LAS __attribute__((address_space(3)))
typedef unsigned short bf16_t;
typedef float f32x4 __attribute__((ext_vector_type(4)));
typedef float f32x16 __attribute__((ext_vector_type(16)));
typedef short bf16x8 __attribute__((ext_vector_type(8)));
typedef unsigned u32x4 __attribute__((ext_vector_type(4)));
typedef unsigned u32x2 __attribute__((ext_vector_type(2)));
typedef float f32x2_t __attribute__((ext_vector_type(2)));
typedef __bf16 bf16x2_t __attribute__((ext_vector_type(2)));

__device__ __forceinline__ unsigned pk2(float lo, float hi) { f32x2_t v = {lo, hi}; bf16x2_t b = __builtin_convertvector(v, bf16x2_t); return __builtin_bit_cast(unsigned, b); }
__device__ __forceinline__ float bf_lo(unsigned w) { return __uint_as_float(w << 16); }
__device__ __forceinline__ float bf_hi(unsigned w) { return __uint_as_float(w & 0xffff0000u); }
__device__ __forceinline__ float wave_sum(float v) {
#pragma unroll
    for (int o = 1; o < 64; o <<= 1) v += __shfl_xor(v, o);
    return v;
}
__device__ __forceinline__ float silu_f(float x) { return x * __builtin_amdgcn_rcpf(1.0f + __builtin_amdgcn_exp2f(-x * LOG2E)); }

struct Args {
    const float* in[16]; float* out; unsigned char* ws; int ph_lo, ph_hi;
};
typedef const __attribute__((address_space(4))) char* kargp_t;
__device__ __forceinline__ kargp_t kargs_() { kargp_t p = (kargp_t)__builtin_amdgcn_kernarg_segment_ptr(); asm volatile("" : "+s"(p)); return p; }
#define ARG_IN(k) (*(const float* const __attribute__((address_space(4)))*)(kargs_() + 8 * (k)))
#define ARG_OUT() (*(float* const __attribute__((address_space(4)))*)(kargs_() + 128))
#define ARG_WS() (*(unsigned char* const __attribute__((address_space(4)))*)(kargs_() + 136))
__device__ __forceinline__ int fresh_lane() { unsigned z = 0u; asm volatile("" : "+v"(z)); return (int)__builtin_amdgcn_mbcnt_hi(~0u, __builtin_amdgcn_mbcnt_lo(~0u, z)); }

__device__ __forceinline__ void p0_transpose_item(const float* W, int K, int N, const float* g, bf16_t* WT, int dst_row0, LAS float* scr, int k0, int n0, int lane) {
#pragma unroll 8
    for (int i = 0; i < 32; ++i) { const int kk = 2 * i + (lane >> 5); scr[kk * 33 + (lane & 31)] = W[(size_t)(k0 + kk) * N + n0 + (lane & 31)]; }
    asm volatile("s_waitcnt lgkmcnt(0)" ::: "memory");
    const int c = lane & 7;
    f32x4 ga = {1.f, 1.f, 1.f, 1.f}, gb = {1.f, 1.f, 1.f, 1.f};
    if (g) { ga = *(const f32x4*)(g + k0 + 8 * c); gb = *(const f32x4*)(g + k0 + 8 * c + 4); }
#pragma unroll
    for (int j = 0; j < 4; ++j) { const int n = (lane >> 3) + 8 * j; const LAS float* s = scr + (8 * c) * 33 + n;
        u32x4 o; o.x = pk2(s[0 * 33] * ga[0], s[1 * 33] * ga[1]); o.y = pk2(s[2 * 33] * ga[2], s[3 * 33] * ga[3]); o.z = pk2(s[4 * 33] * gb[0], s[5 * 33] * gb[1]); o.w = pk2(s[6 * 33] * gb[2], s[7 * 33] * gb[3]);
        *(u32x4*)(WT + (size_t)(dst_row0 + n) * K + k0 + 8 * c) = o; }
    asm volatile("s_waitcnt lgkmcnt(0)" ::: "memory");
}
__device__ __forceinline__ int win_dst_row(int n) {
    const int seg = n >> 10, o = n & 1023;
    switch (seg) { case 0: return o; case 1: return 1024 + o; case 2: return 6144 + o; case 3: return 2048 + o; case 4: return 3072 + o; case 5: return 7168 + o; default: return 4096 + (n - 6144); }
}
__device__ __forceinline__ void norm_row_to_bf16(const float* xrow, bf16_t* orow, int lane) {
    const f32x4* xr = (const f32x4*)xrow + lane;
    f32x4 v[8]; float s = 0.f;
#pragma unroll
    for (int j = 0; j < 8; ++j) { v[j] = xr[64 * j]; s += (v[j][0] * v[j][0] + v[j][1] * v[j][1]) + (v[j][2] * v[j][2] + v[j][3] * v[j][3]); }
    const float r = 1.0f / sqrtf(wave_sum(s) * (1.0f / DM) + EPS);
    u32x2* o8 = (u32x2*)orow + lane;
#pragma unroll
    for (int j = 0; j < 8; ++j) { u32x2 w; w.x = pk2(v[j][0] * r, v[j][1] * r); w.y = pk2(v[j][2] * r, v[j][3] * r); o8[64 * j] = w; }
}
__device__ __forceinline__ void p0_prologue(LAS unsigned char* lds, int wave) {
    const int lane = fresh_lane();
    unsigned char* ws = ARG_WS();
    LAS float* scr = (LAS float*)(lds + wave * 16384);
    const int gw = blockIdx.x * NWAVES + wave, NGW = gridDim.x * NWAVES;
    constexpr int I_IN = 32 * 256, I_OUT = 32 * 64, I_Q = 32 * 16, I_KV = 32 * 32, I_O = 8 * 64, NITEMS = I_IN + I_OUT + I_Q + I_KV + I_O;
    for (int it = gw; it < NITEMS; it += NGW) {
        int r = it;
        if (r < I_IN) { const int kb = r >> 8, nb = r & 255; p0_transpose_item(ARG_IN(3), DM, 8192, ARG_IN(2), (bf16_t*)(ws + WS_WTIN), win_dst_row(32 * nb), scr, 64 * kb, 32 * nb, lane); continue; } r -= I_IN;
        if (r < I_OUT) { const int kb = r >> 6, nb = r & 63; p0_transpose_item(ARG_IN(9), DM, DM, nullptr, (bf16_t*)(ws + WS_WTOUT), 32 * nb, scr, 64 * kb, 32 * nb, lane); continue; } r -= I_OUT;
        if (r < I_Q) { const int kb = r >> 4, nb = r & 15; p0_transpose_item(ARG_IN(12), DM, MEMW, ARG_IN(10), (bf16_t*)(ws + WS_WTQ), 32 * nb, scr, 64 * kb, 32 * nb, lane); continue; } r -= I_Q;
        if (r < I_KV) { const int kb = r >> 5, nb = r & 31; p0_transpose_item(ARG_IN(13), DM, 2 * MEMW, ARG_IN(11), (bf16_t*)(ws + WS_WTKV), 32 * nb, scr, 64 * kb, 32 * nb, lane); continue; } r -= I_KV;
        { const int kb = r >> 6, nb = r & 63; p0_transpose_item(ARG_IN(14), MEMW, DM, nullptr, (bf16_t*)(ws + WS_WTO), 32 * nb, scr, 64 * kb, 32 * nb, lane); }
    }
    for (int m = gw; m < MROWS + MEMROWS; m += NGW) {
        if (m < MROWS) norm_row_to_bf16(ARG_IN(0) + (size_t)m * DM, (bf16_t*)(ws + WS_XB) + (size_t)m * DM, lane);
        else norm_row_to_bf16(ARG_IN(1) + (size_t)(m - MROWS) * DM, (bf16_t*)(ws + WS_MEMB) + (size_t)(m - MROWS) * DM, lane);
    }
}

__device__ __forceinline__ void p2_kmean(LAS unsigned char* lds, int wave) {
    const int lane = fresh_lane(), tid = wave * 64 + lane;
    const bf16_t* qkg = (const bf16_t*)(ARG_WS() + WS_QKG); float* kmean = (float*)(ARG_WS() + WS_KMEAN);
    LAS float* red = (LAS float*)lds;
    for (int it = blockIdx.x; it < BATCH * 8 * 16; it += gridDim.x) {
        const int n = it & 15, h = (it >> 4) & 7, b = it >> 7;
        const bf16_t* src = qkg + (size_t)(b * SEQ + n * 256 + wave * 32) * NQKG + 3072 + h * 128 + 2 * lane;
        float s0 = 0.f, s1 = 0.f;
#pragma unroll 8
        for (int k = 0; k < 32; ++k) { const unsigned w = *(const unsigned*)(src + (size_t)k * NQKG); s0 += bf_lo(w); s1 += bf_hi(w); }
        red[wave * 128 + 2 * lane] = s0; red[wave * 128 + 2 * lane + 1] = s1;
        __syncthreads();
        if (tid < 128) { float s = 0.f;
#pragma unroll
            for (int w = 0; w < 8; ++w) s += red[w * 128 + tid];
            kmean[(size_t)it * 128 + tid] = s * (1.0f / 256.0f); }
        __syncthreads();
    }
}

struct AttnArgs {
    const bf16_t* qkg; const bf16_t* vt; const float* kmean; bf16_t* y;
    const bf16_t* qm; const bf16_t* kmem; const bf16_t* vmemt; bf16_t* om;
    const float* subln_g; float lam;
};
__device__ __forceinline__ int kperm(int i) { return (i & 0x13) | ((i & 4) << 1) | ((i & 8) >> 1); }

#ifndef ATT_SCHED_FENCE
#define ATT_SCHED_FENCE() __builtin_amdgcn_sched_barrier(0)
#endif
template <int MODE>
__device__ __forceinline__ void attn_unit(LAS unsigned char* lds, const AttnArgs& A, int b, int h, int ui, int wid, int lane) {
    constexpr int NKS = (MODE == 0) ? 4 : 8;
    const float NEG_INF = -__builtin_inff();
    const int tid = wid * 64 + lane, i32 = lane & 31, hi = lane >> 5;
    const int comp = (MODE == 0) ? (wid >> 2) : 0, qb = (MODE == 0) ? (wid & 3) : wid;
    const int q0 = (MODE == 0) ? ui * 128 : ui * 256;
    const int q0w = q0 + 32 * qb;
    const int qpos = q0w + i32;
    const size_t tok = (size_t)b * SEQ + qpos;
    const bf16_t *Qg, *Kg, *Vg; int kp, vp;
    if (MODE == 0) { Qg = A.qkg + tok * NQKG + h * 128 + comp * 64; Kg = A.qkg + (size_t)(b * SEQ) * NQKG + 1024 + h * 128; kp = NQKG; Vg = A.vt + (size_t)(h * 128) * MROWS + b * SEQ; vp = MROWS; }
    else if (MODE == 1) { Qg = A.qkg + tok * NQKG + 2048 + h * 128; Kg = A.qkg + (size_t)(b * SEQ) * NQKG + 3072 + h * 128; kp = NQKG; Vg = A.vt + (size_t)(1024 + h * 128) * MROWS + b * SEQ; vp = MROWS; }
    else { Qg = A.qm + tok * MEMW + h * 128; Kg = A.kmem + (size_t)(b * MEMLEN) * MEMW + h * 128; kp = MEMW; Vg = A.vmemt + (size_t)(h * 128) * MEMROWS + b * MEMLEN; vp = MEMROWS; }
    bf16x8 qf[NKS];
#pragma unroll
    for (int ks = 0; ks < NKS; ++ks) qf[ks] = *(const bf16x8*)(Qg + ks * 16 + hi * 8);
    const float slope2 = (MODE == 2) ? 0.f : LOG2E / (float)(1 << (h + 1));

    unsigned sel = 0u, wsel = 0u; unsigned long long tmask;
    if (MODE == 0) { const int nt = 2 * (ui + 1); tmask = (nt >= 64) ? ~0ull : ((1ull << nt) - 1ull); }
    else if (MODE == 2) tmask = 0xFull;
    else {
        const int c = ui;
        LAS float* km = (LAS float*)(lds + XCH_OFF);
        LAS unsigned* wm = (LAS unsigned*)(lds + XCH_OFF + 8192);
        if (c > 0) {
            *(LAS f32x4*)(km + tid * 4) = *(const f32x4*)(A.kmean + (size_t)((b * 8 + h) * 16) * 128 + tid * 4);
            __syncthreads();
            float sc[16];
#pragma unroll
            for (int n = 0; n < 16; ++n) { sc[n] = NEG_INF;
                if (n < c) { float acc = 0.f;
#pragma unroll
                    for (int ks = 0; ks < NKS; ++ks) { const f32x4 k0 = *(const LAS f32x4*)(km + n * 128 + ks * 16 + hi * 8), k1 = *(const LAS f32x4*)(km + n * 128 + ks * 16 + hi * 8 + 4);
#pragma unroll
                        for (int e = 0; e < 4; ++e) { acc = fmaf(__uint_as_float((unsigned)(unsigned short)qf[ks][e] << 16), k0[e], acc); acc = fmaf(__uint_as_float((unsigned)(unsigned short)qf[ks][4 + e] << 16), k1[e], acc); } }
                    acc += __shfl_xor(acc, 32); sc[n] = acc; } }
#pragma unroll
            for (int k = 0; k < 3; ++k) { float best = NEG_INF; int bi = -1;
#pragma unroll
                for (int n = 0; n < 16; ++n) { const bool ok = (n < c) && !((sel >> n) & 1u) && (sc[n] > best); best = ok ? sc[n] : best; bi = ok ? n : bi; }
                if (bi >= 0) sel |= 1u << bi; }
            wsel = sel;
#pragma unroll
            for (int o = 1; o < 64; o <<= 1) wsel |= (unsigned)__shfl_xor((int)wsel, o);
            wsel = __builtin_amdgcn_readfirstlane(wsel);
        }
        if (lane == 0) wm[wid] = wsel;
        __syncthreads();
        unsigned bm = 1u << c;
#pragma unroll
        for (int w = 0; w < 8; ++w) bm |= wm[w];
        bm = __builtin_amdgcn_readfirstlane(bm);
        tmask = 0ull;
#pragma unroll
        for (int n = 0; n < 16; ++n) if ((bm >> n) & 1u) tmask |= 0xFull << (4 * n);
    }

    const int kpi = kperm(i32), kx = kpi & 15;
    int kaddr[NKS], vaddr[4];
#pragma unroll
    for (int ks = 0; ks < NKS; ++ks) kaddr[ks] = kpi * 256 + ((((MODE == 0 ? comp * 8 : 0) + 2 * ks + hi) ^ kx) << 4);
#pragma unroll
    for (int s = 0; s < 4; ++s) vaddr[s] = i32 * 128 + (((2 * s + hi) ^ ((i32 >> 1) & 7)) << 4);
    const int srow = tid >> 3, sch = tid & 7;
    const int kst0 = srow * 256 + ((sch ^ (srow & 15)) << 4), kst1 = srow * 256 + (((sch + 8) ^ (srow & 15)) << 4);
    const int vst0 = 16384 + srow * 128 + ((sch ^ ((srow >> 1) & 7)) << 4), vst1 = vst0 + 8192;
    const bf16_t* ksrc = Kg + (size_t)srow * kp + sch * 8;
    const bf16_t* vsrc = Vg + (size_t)srow * vp + sch * 8;

    f32x16 O[4];
#pragma unroll
    for (int dt = 0; dt < 4; ++dt)
#pragma unroll
        for (int r = 0; r < 16; ++r) O[dt][r] = 0.f;
    float m_run = -1.0e30f, l_run = 0.f;

    u32x4 kr0, kr1, vr0, vr1;
#define ATT_LOAD(t) do { const bf16_t* kp_ = ksrc + (size_t)(64 * (t)) * kp; const bf16_t* vp_ = vsrc + 64 * (t); \
        kr0 = *(const u32x4*)kp_; kr1 = *(const u32x4*)(kp_ + 64); vr0 = *(const u32x4*)vp_; vr1 = *(const u32x4*)(vp_ + (size_t)64 * vp); } while (0)
#define ATT_STORE(buf) do { LAS unsigned char* b_ = lds + (buf) * 32768; \
        *(LAS u32x4*)(b_ + kst0) = kr0; *(LAS u32x4*)(b_ + kst1) = kr1; *(LAS u32x4*)(b_ + vst0) = vr0; *(LAS u32x4*)(b_ + vst1) = vr1; } while (0)

    unsigned long long rem = tmask;
    int t = __builtin_ctzll(rem); rem &= rem - 1ull;
    ATT_LOAD(t); ATT_STORE(0); __syncthreads();
    int cur = 0;
    for (;;) {
        int tn = -1;
        if (rem) { tn = __builtin_ctzll(rem); rem &= rem - 1ull; }
        if (tn >= 0) ATT_LOAD(tn);
        {
            const int key0 = 64 * t;
            bool act = true, diag = false, dead = false;
            if (MODE == 0) { act = key0 <= q0w + 31; diag = key0 + 63 > q0w; }
            if (MODE == 1) { const int n = t >> 2; if (n < ui) { act = (wsel >> n) & 1u; dead = !((sel >> n) & 1u); } else { act = key0 <= q0w + 31; diag = key0 + 63 > q0w; } }
            if (act) {
                const LAS unsigned char* kb = lds + cur * 32768; const LAS unsigned char* vb = kb + 16384;
                f32x16 S0, S1;
                if (MODE == 2) {
#pragma unroll
                    for (int r = 0; r < 16; ++r) { S0[r] = 0.f; S1[r] = 0.f; }
                } else {
                    const int rel = key0 + 8 * hi - qpos;
                    const float tb = slope2 * (float)rel;
#pragma unroll
                    for (int r = 0; r < 16; ++r) { const int ko0 = (r & 7) + 16 * (r >> 3), ko1 = 32 + ko0;
                        float v0 = fmaf(slope2, (float)ko0, tb), v1 = fmaf(slope2, (float)ko1, tb);
                        if (diag) { if (rel + ko0 > 0) v0 = NEG_INF; if (rel + ko1 > 0) v1 = NEG_INF; }
                        if (dead) { v0 = NEG_INF; v1 = NEG_INF; }
                        S0[r] = v0; S1[r] = v1; }
                }
#pragma unroll
                for (int ks = 0; ks < NKS; ++ks) {
                    const bf16x8 k0 = *(const LAS bf16x8*)(kb + kaddr[ks]), k1 = *(const LAS bf16x8*)(kb + kaddr[ks] + 8192);
                    S0 = __builtin_amdgcn_mfma_f32_32x32x16_bf16(k0, qf[ks], S0, 0, 0, 0);
                    S1 = __builtin_amdgcn_mfma_f32_32x32x16_bf16(k1, qf[ks], S1, 0, 0, 0);
                    if ((ks & 1) == 1) ATT_SCHED_FENCE();
                }
                float mx = fmaxf(S0[0], S1[0]);
#pragma unroll
                for (int r = 1; r < 16; ++r) mx = fmaxf(mx, fmaxf(S0[r], S1[r]));
                mx = fmaxf(mx, __shfl_xor(mx, 32));
                const float mn = fmaxf(m_run, mx);
                const float alpha = __builtin_amdgcn_exp2f(m_run - mn);
                m_run = mn;
                float ls = 0.f;
#pragma unroll
                for (int r = 0; r < 16; ++r) { S0[r] = __builtin_amdgcn_exp2f(S0[r] - mn); S1[r] = __builtin_amdgcn_exp2f(S1[r] - mn); ls += S0[r] + S1[r]; }
                l_run = l_run * alpha + ls;
#pragma unroll
                for (int dt = 0; dt < 4; ++dt)
#pragma unroll
                    for (int r = 0; r < 16; ++r) O[dt][r] *= alpha;
                u32x4 pw[4];
#pragma unroll
                for (int s = 0; s < 4; ++s) {
                    const int r0 = 8 * (s & 1);
                    if (s < 2) { pw[s].x = pk2(S0[r0], S0[r0 + 1]); pw[s].y = pk2(S0[r0 + 2], S0[r0 + 3]); pw[s].z = pk2(S0[r0 + 4], S0[r0 + 5]); pw[s].w = pk2(S0[r0 + 6], S0[r0 + 7]); }
                    else { pw[s].x = pk2(S1[r0], S1[r0 + 1]); pw[s].y = pk2(S1[r0 + 2], S1[r0 + 3]); pw[s].z = pk2(S1[r0 + 4], S1[r0 + 5]); pw[s].w = pk2(S1[r0 + 6], S1[r0 + 7]); }
                }
#pragma unroll
                for (int dt = 0; dt < 4; ++dt) {
#pragma unroll
                    for (int s = 0; s < 4; ++s) {
                        const bf16x8 v = *(const LAS bf16x8*)(vb + vaddr[s] + dt * 4096);
                        O[dt] = __builtin_amdgcn_mfma_f32_32x32x16_bf16(v, __builtin_bit_cast(bf16x8, pw[s]), O[dt], 0, 0, 0);
                    }
                    ATT_SCHED_FENCE();
                }
            }
        }
        if (tn >= 0) ATT_STORE(cur ^ 1);
        __syncthreads();
        if (tn < 0) break;
        t = tn; cur ^= 1;
    }
#undef ATT_LOAD
#undef ATT_STORE

    const float lt = l_run + __shfl_xor(l_run, 32);
    const float linv = 1.0f / lt;
    if (MODE == 0) {
        LAS float* xch = (LAS float*)(lds + XCH_OFF);
        if (comp == 1) {
#pragma unroll
            for (int dt = 0; dt < 4; ++dt)
#pragma unroll
                for (int r = 0; r < 16; ++r) xch[(qb * 64 + dt * 16 + r) * 64 + lane] = O[dt][r] * linv;
        }
        __syncthreads();
        if (comp == 0) {
            float ss = 0.f;
#pragma unroll
            for (int dt = 0; dt < 4; ++dt)
#pragma unroll
                for (int r = 0; r < 16; ++r) { const float o2 = xch[(qb * 64 + dt * 16 + r) * 64 + lane]; const float o = O[dt][r] * linv - A.lam * o2; O[dt][r] = o; ss += o * o; }
            ss += __shfl_xor(ss, 32);
            const float rn = 0.8f / sqrtf(ss * (1.0f / 128.0f) + EPS);
            const bf16_t* gp = A.qkg + tok * NQKG + 4096 + h * 128; bf16_t* yp = A.y + tok * DM + h * 128;
#pragma unroll
            for (int dt = 0; dt < 4; ++dt)
#pragma unroll
                for (int g4 = 0; g4 < 4; ++g4) { const int d = 32 * dt + 8 * g4 + 4 * hi;
                    const f32x4 sg = *(const f32x4*)(A.subln_g + d); const u32x2 gw = *(const u32x2*)(gp + d);
                    const float o0 = O[dt][4 * g4 + 0] * rn * sg[0] * silu_f(bf_lo(gw.x)), o1 = O[dt][4 * g4 + 1] * rn * sg[1] * silu_f(bf_hi(gw.x));
                    const float o2 = O[dt][4 * g4 + 2] * rn * sg[2] * silu_f(bf_lo(gw.y)), o3 = O[dt][4 * g4 + 3] * rn * sg[3] * silu_f(bf_hi(gw.y));
                    u32x2 w; w.x = pk2(o0, o1); w.y = pk2(o2, o3); *(u32x2*)(yp + d) = w; }
        }
        __syncthreads();
    } else if (MODE == 1) {
        const bf16_t* gp = A.qkg + tok * NQKG + 4096 + 1024 + h * 128; bf16_t* yp = A.y + tok * DM + 1024 + h * 128;
#pragma unroll
        for (int dt = 0; dt < 4; ++dt)
#pragma unroll
            for (int g4 = 0; g4 < 4; ++g4) { const int d = 32 * dt + 8 * g4 + 4 * hi; const u32x2 gw = *(const u32x2*)(gp + d);
                const float o0 = O[dt][4 * g4 + 0] * linv * silu_f(bf_lo(gw.x)), o1 = O[dt][4 * g4 + 1] * linv * silu_f(bf_hi(gw.x));
                const float o2 = O[dt][4 * g4 + 2] * linv * silu_f(bf_lo(gw.y)), o3 = O[dt][4 * g4 + 3] * linv * silu_f(bf_hi(gw.y));
                u32x2 w; w.x = pk2(o0, o1); w.y = pk2(o2, o3); *(u32x2*)(yp + d) = w; }
    } else {
        bf16_t* op = A.om + tok * MEMW + h * 128;
#pragma unroll
        for (int dt = 0; dt < 4; ++dt)
#pragma unroll
            for (int g4 = 0; g4 < 4; ++g4) { const int d = 32 * dt + 8 * g4 + 4 * hi;
                u32x2 w; w.x = pk2(O[dt][4 * g4 + 0] * linv, O[dt][4 * g4 + 1] * linv); w.y = pk2(O[dt][4 * g4 + 2] * linv, O[dt][4 * g4 + 3] * linv); *(u32x2*)(op + d) = w; }
    }
}

__constant__ const unsigned short ATT_ORDER[48] = {271, 270, 269, 268, 31, 267, 30, 29, 266, 28, 27, 26, 265, 25, 24, 23, 264, 22, 21, 263, 20, 19, 18, 262, 17, 16, 15, 261, 14, 13, 260, 12, 11, 10, 259, 9, 8, 7, 258, 6, 5, 257, 4, 3, 2, 256, 1, 0};

__device__ __forceinline__ void p3_attention(LAS unsigned char* lds, int wave) {
    const int lane = fresh_lane(), tid = wave * 64 + lane;
    AttnArgs A;
    A.qkg = (const bf16_t*)(ARG_WS() + WS_QKG); A.vt = (const bf16_t*)(ARG_WS() + WS_VT); A.kmean = (const float*)(ARG_WS() + WS_KMEAN); A.y = (bf16_t*)(ARG_WS() + WS_Y);
    A.qm = nullptr; A.kmem = nullptr; A.vmemt = nullptr; A.om = nullptr; A.subln_g = ARG_IN(8);
    { const float s1 = wave_sum(ARG_IN(4)[lane] * ARG_IN(5)[lane]), s2 = wave_sum(ARG_IN(6)[lane] * ARG_IN(7)[lane]); A.lam = expf(s1) - expf(s2) + 0.2f; }
    unsigned* qhead = (unsigned*)(ARG_WS() + WS_CTL) + CW_QUEUE;
    LAS unsigned* slot = (LAS unsigned*)(lds + MISC_OFF);
    for (;;) {
        if (tid == 0) slot[0] = atomicAdd(qhead, 1u);
        __syncthreads();
        const int item = __builtin_amdgcn_readfirstlane((int)slot[0]);
        __syncthreads();
        if (item >= 768) break;
        const int bh = item & 15, e = ATT_ORDER[item >> 4];
        const int b = bh >> 3, h = bh & 7, idx = e & 255;
        if (e >> 8) attn_unit<1>(lds, A, b, h, idx, wave, lane); else attn_unit<0>(lds, A, b, h, idx, wave, lane);
    }
}
__device__ __forceinline__ void p6_cross(LAS unsigned char* lds, int wave) {
    const int lane = fresh_lane();
    AttnArgs A;
    A.qkg = nullptr; A.vt = nullptr; A.kmean = nullptr; A.y = nullptr; A.subln_g = nullptr; A.lam = 0.f;
    A.qm = (const bf16_t*)(ARG_WS() + WS_QM); A.kmem = (const bf16_t*)(ARG_WS() + WS_KMEM); A.vmemt = (const bf16_t*)(ARG_WS() + WS_VMEMT); A.om = (bf16_t*)(ARG_WS() + WS_OM);
    for (int u = blockIdx.x; u < BATCH * 4 * 16; u += gridDim.x) attn_unit<2>(lds, A, u >> 6, (u >> 4) & 3, u & 15, wave, lane);
}

__device__ __forceinline__ void p8_final(int wave) {
    const int lane = fresh_lane();
    const float* part2 = (const float*)(ARG_WS() + WS_PART2); const float* g = ARG_IN(15);
    const int gw = blockIdx.x * NWAVES + wave, NGW = gridDim.x * NWAVES;
    for (int m = gw; m < MROWS; m += NGW) {
        const float p = (lane < 32) ? part2[(size_t)m * 32 + lane] : 0.f;
        const float r = 1.0f / sqrtf(wave_sum(p) * (1.0f / DM) + EPS);
        f32x4* o = (f32x4*)(ARG_OUT() + (size_t)m * DM) + lane; const f32x4* gg = (const f32x4*)g + lane;
#pragma unroll
        for (int j = 0; j < 8; ++j) { const f32x4 v = o[64 * j]; o[64 * j] = v * r * gg[64 * j]; }
    }
}

__global__ void __launch_bounds__(NWAVES * 64, 2) mega_fwd(Args a) {
    extern __shared__ __attribute__((aligned(16))) unsigned char lds_raw[];
    LAS unsigned char* lds = (LAS unsigned char*)lds_raw;
    const int wave = __builtin_amdgcn_readfirstlane((int)threadIdx.x >> 6);
    const int G = gridDim.x, bx = blockIdx.x;
    const int lo = a.ph_lo, hi = a.ph_hi;
#define ws ARG_WS()
#ifndef PHASE_MASK
#define PHASE_MASK 0x1ff
#endif
#define IN(k) (((PHASE_MASK >> (k)) & 1) && lo <= (k) && (k) < hi)
#define GRID_BAR(k) do { if (IN(k) && IN((k) + 1)) { cg::this_grid().sync(); } } while (0)
    typedef pg8::bf16_t pbf;
    if (IN(0)) { p0_prologue(lds, wave); }
    GRID_BAR(0);
    if (IN(1)) {
        { pg8::Gemm g{(const pbf*)(ws + WS_XB), (const pbf*)(ws + WS_WTIN), MROWS, NQKG, DM}; pg8::StaticOrder S; S.init(MROWS, NQKG, G, bx);
          pg8::EpiScaleBf16 E{(pbf*)(ws + WS_QKG), NQKG, 0, 1024, 0.125f * LOG2E, 2048, 3072, 0.08838834764831845f * LOG2E};
          pg8::gemm_phase<pg8::EpiScaleBf16, pg8::StaticOrder, true, true>(lds, g, S, E, wave); }
        { pg8::Gemm g{(const pbf*)(ws + WS_WTIN) + (size_t)NQKG * DM, (const pbf*)(ws + WS_XB), NVT, MROWS, DM}; pg8::StaticOrder S; S.init(NVT, MROWS, G, bx);
          pg8::EpiScaleBf16 E{(pbf*)(ws + WS_VT), MROWS, 0, 0, 1.f, 0, 0, 1.f};
          pg8::gemm_phase<pg8::EpiScaleBf16, pg8::StaticOrder, true, true>(lds, g, S, E, wave); }
    }
    GRID_BAR(1);
    if (IN(2)) { p2_kmean(lds, wave); }
    GRID_BAR(2);
    if (IN(3)) { p3_attention(lds, wave); }
    GRID_BAR(3);
    if (IN(4)) {
        pg8::Gemm g{(const pbf*)(ws + WS_Y), (const pbf*)(ws + WS_WTOUT), MROWS, DM, DM}; pg8::StaticOrder S; S.init(MROWS, DM, G, bx);
        pg8::EpiResid E{ARG_IN(0), (float*)(ws + WS_X1), (pbf*)(ws + WS_X1B), (float*)(ws + WS_PART1), DM};
        pg8::gemm_phase<pg8::EpiResid, pg8::StaticOrder, false, true>(lds, g, S, E, wave);
    }
    GRID_BAR(4);
    if (IN(5)) {
        { pg8::Gemm g{(const pbf*)(ws + WS_X1B), (const pbf*)(ws + WS_WTQ), MROWS, MEMW, DM}; pg8::StaticOrder S; S.init(MROWS, MEMW, G, bx);
          pg8::EpiRowNormBf16 E{(pbf*)(ws + WS_QM), MEMW, (const float*)(ws + WS_PART1), 0.08838834764831845f * LOG2E, 1.0f / DM, EPS};
          pg8::gemm_phase<pg8::EpiRowNormBf16, pg8::StaticOrder, false, true>(lds, g, S, E, wave); }
        { pg8::Gemm g{(const pbf*)(ws + WS_MEMB), (const pbf*)(ws + WS_WTKV), MEMROWS, MEMW, DM}; pg8::StaticOrder S; S.init(MEMROWS, MEMW, G, (bx + G - 64) % G);
          pg8::EpiScaleBf16 E{(pbf*)(ws + WS_KMEM), MEMW, 0, 0, 1.f, 0, 0, 1.f};
          pg8::gemm_phase<pg8::EpiScaleBf16, pg8::StaticOrder, false, true>(lds, g, S, E, wave); }
        { pg8::Gemm g{(const pbf*)(ws + WS_WTKV) + (size_t)MEMW * DM, (const pbf*)(ws + WS_MEMB), MEMW, MEMROWS, DM}; pg8::StaticOrder S; S.init(MEMW, MEMROWS, G, (bx + G - 68) % G);
          pg8::EpiScaleBf16 E{(pbf*)(ws + WS_VMEMT), MEMROWS, 0, 0, 1.f, 0, 0, 1.f};
          pg8::gemm_phase<pg8::EpiScaleBf16, pg8::StaticOrder, false, true>(lds, g, S, E, wave); }
    }
    GRID_BAR(5);
    if (IN(6)) { p6_cross(lds, wave); }
    GRID_BAR(6);
    if (IN(7)) {
        pg8::Gemm g{(const pbf*)(ws + WS_OM), (const pbf*)(ws + WS_WTO), MROWS, DM, MEMW}; pg8::StaticOrder S; S.init(MROWS, DM, G, bx);
        pg8::EpiResid E{(const float*)(ws + WS_X1), ARG_OUT(), nullptr, (float*)(ws + WS_PART2), DM};
        pg8::gemm_phase<pg8::EpiResid, pg8::StaticOrder, false, true>(lds, g, S, E, wave);
    }
    GRID_BAR(7);
    if (IN(8)) { p8_final(wave); }
#undef IN
#undef GRID_BAR
#undef ws
}

extern "C" void kernel_launch(void* const* d_in, const int* in_sizes, int n_in, void* d_out, int out_size, void* d_ws, size_t ws_size, hipStream_t stream) {
    static int grid = 0;
    if (grid == 0) {
        if (n_in != 16 || out_size != MROWS * DM || ws_size < WS_END) { fprintf(stderr, "kernel_launch: unexpected shapes (n_in %d out %d ws %zu)\n", n_in, out_size, ws_size); grid = -1; return; }
        int dev = 0, cus = 0, per_cu = 0;
        if (hipGetDevice(&dev) != hipSuccess || hipDeviceGetAttribute(&cus, hipDeviceAttributeMultiprocessorCount, dev) != hipSuccess) { grid = -1; return; }
        if (hipFuncSetAttribute((const void*)mega_fwd, hipFuncAttributeMaxDynamicSharedMemorySize, LDS_BYTES) != hipSuccess) { fprintf(stderr, "kernel_launch: hipFuncSetAttribute failed\n"); grid = -1; return; }
        if (hipOccupancyMaxActiveBlocksPerMultiprocessor(&per_cu, (const void*)mega_fwd, NWAVES * 64, LDS_BYTES) != hipSuccess || per_cu < 1) { fprintf(stderr, "kernel_launch: occupancy query says %d\n", per_cu); per_cu = 1; }
        (void)hipGetLastError();
        grid = cus;
    }
    if (grid < 0) return;
    (void)hipMemsetAsync((char*)d_ws + WS_CTL, 0, CTL_ZERO_BYTES, stream);
    Args a{};
    for (int i = 0; i < 16; ++i) a.in[i] = (const float*)d_in[i];
    a.out = (float*)d_out; a.ws = (unsigned char*)d_ws;
    if (N_LAUNCHES == 1) {
        a.ph_lo = 0; a.ph_hi = N_PHASES;
        void* args[] = {&a};
        hipError_t e = hipLaunchCooperativeKernel((const void*)mega_fwd, dim3(grid), dim3(NWAVES * 64), args, LDS_BYTES, stream);
        if (e != hipSuccess) fprintf(stderr, "kernel_launch: cooperative launch failed: %s (grid %d)\n", hipGetErrorString(e), grid);
    } else {
        for (int p = 0; p < N_PHASES; ++p) {
            a.ph_lo = p; a.ph_hi = p + 1;
            hipLaunchKernelGGL(mega_fwd, dim3(grid), dim3(NWAVES * 64), LDS_BYTES, stream, a);
        }
    }
}
```

```cpp
#include <hip/hip_runtime.h>
#include <hip/hip_cooperative_groups.h>
#include <cstdio>
#include <cstdint>


#ifndef MK_N_LAUNCHES
#define MK_N_LAUNCHES 1
#endif
namespace pg8 {
#define PG8_LAS __attribute__((address_space(3)))
typedef unsigned short bf16_t;
typedef short bf16x8 __attribute__((ext_vector_type(8)));
typedef float f32x4 __attribute__((ext_vector_type(4)));
typedef unsigned u32x4 __attribute__((ext_vector_type(4)));
constexpr int BM = 256, BK = 64, HALF = 128, HTB = HALF * BK * 2  , STAGE_BYTES = 8 * HTB, NXCD = 8, WGM = 8;

__host__ __device__ __forceinline__ int lds_byte(int r, int c) { const int st = (r >> 4) * 2 + (c >> 5), rr = r & 15, cc = c & 31, ob = rr * 64 + cc * 2; return st * 1024 + (ob ^ (((ob >> 9) & 1) << 5)); }
__host__ __device__ __forceinline__ void stage_rc(int b, int& R, int& C) { const int st = b / 1024, sb = b % 1024, swz = sb ^ (((sb >> 9) & 1) << 5); R = (st >> 1) * 16 + swz / 64; C = (st & 1) * 32 + (swz % 64) / 2; }
__host__ __device__ __forceinline__ int perm32(int rho) { const int n = rho >> 4, i = rho & 15; return 8 * (i >> 2) + 4 * n + (i & 3); }

struct Unit { int pm, pn; };
struct Gemm { const bf16_t* A; const bf16_t* Bt; int M, N, K; };

struct StaticOrder {
    int nM, nN, nwg, G, c;
    __host__ __device__ void init(int M, int N, int G_, int c_) { nM = M / BM; nN = N / BM; nwg = nM * nN; G = G_; c = c_; }
    __host__ __device__ bool next(int i, Unit& u) const {
        const long L = (long)i * G + c; if (L >= nwg) return false;
        int wgid = (int)L; { const int q = nwg / NXCD, r = nwg % NXCD, xcd = wgid % NXCD, off = wgid / NXCD; wgid = (xcd < r ? xcd * (q + 1) : r * (q + 1) + (xcd - r) * q) + off; }
        const int nig = WGM * nN, gid = wgid / nig, fm = gid * WGM, gsz = (nM - fm) < WGM ? (nM - fm) : WGM;
        u.pm = fm + ((wgid % nig) % gsz); u.pn = (wgid % nig) / gsz; return true;
    }
    __device__ __forceinline__ void a_ready(const Unit&) const {}
    __device__ __forceinline__ void done(const Unit&) const {}
};

__device__ __forceinline__ unsigned cvt_pk_bf16(float lo, float hi) { unsigned r; asm volatile("v_cvt_pk_bf16_f32 %0, %1, %2" : "=v"(r) : "v"(lo), "v"(hi)); return r; }
typedef float f32x2 __attribute__((ext_vector_type(2)));
struct EpiScaleBf16 {
    static constexpr bool PERM = true, AFTER_DRAIN = false;
    bf16_t* O; int ldc; int c0lo, c0hi; float s0; int c1lo, c1hi; float s1;
    __device__ __forceinline__ void operator()(const f32x4 (&acc)[2][2][4][2], const Unit& u, int wr, int wc, int fr, int fq) const {
        const int colt = u.pn * BM;
        const float sc = (colt >= c0lo && colt < c0hi) ? s0 : ((colt >= c1lo && colt < c1hi) ? s1 : 1.f);
        const int row0 = u.pm * BM + wr * 64 + fr, col0 = colt + wc * 32 + 8 * fq;
#pragma unroll
        for (int ai = 0; ai < 2; ++ai)
#pragma unroll
            for (int m = 0; m < 4; ++m) { bf16_t* rowp = O + (size_t)(row0 + ai * HALF + m * 16) * ldc + col0;
#pragma unroll
                for (int bj = 0; bj < 2; ++bj) { const f32x4 v0 = acc[ai][bj][m][0] * sc, v1 = acc[ai][bj][m][1] * sc;
                    u32x4 w; w.x = cvt_pk_bf16(v0[0], v0[1]); w.y = cvt_pk_bf16(v0[2], v0[3]); w.z = cvt_pk_bf16(v1[0], v1[1]); w.w = cvt_pk_bf16(v1[2], v1[3]);
                    *(u32x4*)(rowp + bj * HALF) = w; } }
    }
};
struct EpiResid {
    static constexpr bool PERM = true, AFTER_DRAIN = false;
    const float* base; float* out; bf16_t* outb; float* part; int ldc;
    __device__ __forceinline__ void operator()(const f32x4 (&acc)[2][2][4][2], const Unit& u, int wr, int wc, int fr, int fq) const {
        const int row0 = u.pm * BM + wr * 64 + fr, col0 = u.pn * BM + wc * 32 + 8 * fq;
#pragma unroll
        for (int ai = 0; ai < 2; ++ai)
#pragma unroll
            for (int m = 0; m < 4; ++m) { const int row = row0 + ai * HALF + m * 16; const size_t off = (size_t)row * ldc + col0; float ss = 0.f;
#pragma unroll
                for (int bj = 0; bj < 2; ++bj) {
                    const f32x4 b0 = *(const f32x4*)(base + off + bj * HALF), b1 = *(const f32x4*)(base + off + bj * HALF + 4);
                    const f32x4 v0 = acc[ai][bj][m][0] + b0, v1 = acc[ai][bj][m][1] + b1;
                    *(f32x4*)(out + off + bj * HALF) = v0; *(f32x4*)(out + off + bj * HALF + 4) = v1;
                    if (outb) { u32x4 w; w.x = cvt_pk_bf16(v0[0], v0[1]); w.y = cvt_pk_bf16(v0[2], v0[3]); w.z = cvt_pk_bf16(v1[0], v1[1]); w.w = cvt_pk_bf16(v1[2], v1[3]);
                        *(u32x4*)(outb + off + bj * HALF) = w; }
                    ss += (v0[0] * v0[0] + v0[1] * v0[1]) + (v0[2] * v0[2] + v0[3] * v0[3]) + (v1[0] * v1[0] + v1[1] * v1[1]) + (v1[2] * v1[2] + v1[3] * v1[3]); }
                { const auto r16_ = __builtin_amdgcn_permlane16_swap(__float_as_uint(ss), __float_as_uint(ss), false, false); ss = __uint_as_float(r16_[0]) + __uint_as_float(r16_[1]); const auto r32_ = __builtin_amdgcn_permlane32_swap(__float_as_uint(ss), __float_as_uint(ss), false, false); ss = __uint_as_float(r32_[0]) + __uint_as_float(r32_[1]); }
                if (fq == 0) part[(size_t)row * 32 + u.pn * 4 + wc] = ss; }
    }
};
struct EpiRowNormBf16 {
    static constexpr bool PERM = true, AFTER_DRAIN = false;
    bf16_t* O; int ldc; const float* part; float sc, inv_n, eps;
    __device__ __forceinline__ void operator()(const f32x4 (&acc)[2][2][4][2], const Unit& u, int wr, int wc, int fr, int fq) const {
        const int row0 = u.pm * BM + wr * 64 + fr, col0 = u.pn * BM + wc * 32 + 8 * fq;
#pragma unroll
        for (int ai = 0; ai < 2; ++ai)
#pragma unroll
            for (int m = 0; m < 4; ++m) { const int row = row0 + ai * HALF + m * 16; const f32x4* pp = (const f32x4*)(part + (size_t)row * 32);
                f32x4 s4 = pp[0];
#pragma unroll
                for (int j = 1; j < 8; ++j) s4 = s4 + pp[j];
                const float r = sc / sqrtf(((s4[0] + s4[1]) + (s4[2] + s4[3])) * inv_n + eps);
                bf16_t* rowp = O + (size_t)row * ldc + col0;
#pragma unroll
                for (int bj = 0; bj < 2; ++bj) { const f32x4 v0 = acc[ai][bj][m][0] * r, v1 = acc[ai][bj][m][1] * r;
                    u32x4 w; w.x = cvt_pk_bf16(v0[0], v0[1]); w.y = cvt_pk_bf16(v0[2], v0[3]); w.z = cvt_pk_bf16(v1[0], v1[1]); w.w = cvt_pk_bf16(v1[2], v1[3]);
                    *(u32x4*)(rowp + bj * HALF) = w; } }
    }
};

template <class Epi, class Sched, bool ALIGN_EPI = false, bool SP2 = false>
__device__ __forceinline__ void gemm_phase(PG8_LAS unsigned char* lds, const Gemm g, const Sched& S, const Epi& E, const int wid) {
    unsigned z_ = 0u; asm volatile("" : "+v"(z_)); const int lane = (int)__builtin_amdgcn_mbcnt_hi(~0u, __builtin_amdgcn_mbcnt_lo(~0u, z_)), tid = wid * 64 + lane, wr = wid >> 2, wc = wid & 3, fr = lane & 15, fq = lane >> 4;
    const int K = g.K, nt = K / BK;
    unsigned voffA[2], voffB[2];
#pragma unroll
    for (int i = 0; i < 2; ++i) { int R, C; stage_rc(tid * 16 + i * 8192, R, C); const int Rb = Epi::PERM ? ((R & ~31) + perm32(R & 31)) : R;
        voffA[i] = (unsigned)(R * K + C) * 2u; voffB[i] = (unsigned)(Rb * K + C) * 2u; }
    const size_t kstep = (size_t)(BK * 2);
    const size_t hstep = (size_t)HALF * K * 2;
    const size_t tstep = 2 * hstep;
    const unsigned ldsw = (unsigned)wid * 1024u;
    const int aoff = lds_byte(wr * 64 + fr, fq * 8), boff = lds_byte(wc * 32 + fr, fq * 8);
#define PG8_SA(b, h) (((b) * 2 + (h)) * HTB)
#define PG8_SB(b, h) ((4 + (b) * 2 + (h)) * HTB)
#define PG8_STAGE(bufoff, gbase, voff) do { _Pragma("unroll") for (int _i = 0; _i < 2; ++_i) \
        __builtin_amdgcn_global_load_lds((const unsigned*)((const char*)(gbase) + (voff)[_i]), (PG8_LAS unsigned*)(lds + (bufoff) + ldsw + _i * 8192), 16, 0, 0); } while (0)
#define PG8_LDA(dst, b, h) do { _Pragma("unroll") for (int m = 0; m < 4; ++m) _Pragma("unroll") for (int k = 0; k < 2; ++k) dst[m][k] = *(const PG8_LAS bf16x8*)(lds + PG8_SA(b, h) + aoff + m * 2048 + k * 1024); } while (0)
#define PG8_LDB(dst, b, h) do { _Pragma("unroll") for (int n = 0; n < 2; ++n) _Pragma("unroll") for (int k = 0; k < 2; ++k) dst[n][k] = *(const PG8_LAS bf16x8*)(lds + PG8_SB(b, h) + boff + n * 2048 + k * 1024); } while (0)
#define PG8_MMA(ai, bj, At, Bt) do { __builtin_amdgcn_s_setprio(1); _Pragma("unroll") for (int m = 0; m < 4; ++m) _Pragma("unroll") for (int n = 0; n < 2; ++n) _Pragma("unroll") for (int k = 0; k < 2; ++k) \
        acc[ai][bj][m][n] = __builtin_amdgcn_mfma_f32_16x16x32_bf16(Bt[n][k], At[m][k], acc[ai][bj][m][n], 0, 0, 0); __builtin_amdgcn_s_setprio(0); } while (0)
#define PG8_WAIT_V(n) asm volatile("s_waitcnt vmcnt(" #n ")" ::: "memory")
#define PG8_WAIT_L(n) asm volatile("s_waitcnt lgkmcnt(" #n ")" ::: "memory")
#define PG8_BAR __builtin_amdgcn_s_barrier()
#define PG8_SCHED __builtin_amdgcn_sched_barrier(0)
    Unit cur, nxt; int ui = 0;
    if (!S.next(0, cur)) return;
    f32x4 acc[2][2][4][2];
#pragma unroll
    for (int a = 0; a < 2; ++a)
#pragma unroll
        for (int b = 0; b < 2; ++b)
#pragma unroll
            for (int m = 0; m < 4; ++m)
#pragma unroll
                for (int n = 0; n < 2; ++n) acc[a][b][m][n] = (f32x4){0.f, 0.f, 0.f, 0.f};
    bf16x8 At[4][2], B0[2][2], B1[2][2];
    const char* cA = (const char*)g.A + (size_t)cur.pm * tstep; const char* cB = (const char*)g.Bt + (size_t)cur.pn * tstep;
    S.a_ready(cur);
    if constexpr (SP2) {
        PG8_STAGE(PG8_SB(0, 0), cB, voffB); PG8_STAGE(PG8_SB(0, 1), cB + hstep, voffB); PG8_STAGE(PG8_SA(0, 0), cA, voffA); PG8_STAGE(PG8_SA(0, 1), cA + hstep, voffA);
        if (wr == 1) PG8_BAR;
        PG8_WAIT_V(2); PG8_BAR;
        PG8_STAGE(PG8_SB(1, 0), cB + kstep, voffB); PG8_STAGE(PG8_SA(1, 0), cA + kstep, voffA); PG8_STAGE(PG8_SB(1, 1), cB + hstep + kstep, voffB);
        PG8_WAIT_V(6); PG8_BAR;
    } else {
        PG8_STAGE(PG8_SB(0, 0), cB, voffB); PG8_STAGE(PG8_SA(0, 0), cA, voffA); PG8_STAGE(PG8_SB(0, 1), cB + hstep, voffB); PG8_STAGE(PG8_SA(0, 1), cA + hstep, voffA);
        if (wr == 1) PG8_BAR;
        PG8_WAIT_V(4); PG8_BAR;
        PG8_STAGE(PG8_SB(1, 0), cB + kstep, voffB); PG8_STAGE(PG8_SA(1, 0), cA + kstep, voffA); PG8_STAGE(PG8_SB(1, 1), cB + hstep + kstep, voffB);
        PG8_WAIT_V(6); PG8_BAR;
    }
    for (;;) {
        const bool has_next = S.next(ui + 1, nxt);
        const char* nA = has_next ? (const char*)g.A + (size_t)nxt.pm * tstep : cA; const char* nB = has_next ? (const char*)g.Bt + (size_t)nxt.pn * tstep : cB;
        for (int t = 0; t < nt; t += 2) {
            const bool last = (t == nt - 2);
            const char* a1 = cA + (size_t)(t + 1) * kstep;
            const char* a2 = last ? nA : cA + (size_t)(t + 2) * kstep; const char* b2 = last ? nB : cB + (size_t)(t + 2) * kstep;
            const char* a3 = a2 + kstep; const char* b3 = b2 + kstep;
            if (last && has_next) S.a_ready(nxt);
            if constexpr (SP2) {
            PG8_LDB(B0, 0, 0); PG8_LDB(B1, 0, 1); PG8_SCHED; PG8_LDA(At, 0, 0); PG8_STAGE(PG8_SA(1, 1), a1 + hstep, voffA);
            PG8_WAIT_V(8); PG8_WAIT_L(0); PG8_BAR; PG8_MMA(0, 0, At, B0); PG8_MMA(0, 1, At, B1); PG8_BAR; PG8_SCHED;
            PG8_LDA(At, 0, 1); PG8_STAGE(PG8_SB(0, 0), b2, voffB); PG8_STAGE(PG8_SB(0, 1), b2 + hstep, voffB); PG8_STAGE(PG8_SA(0, 0), a2, voffA);
            PG8_WAIT_V(8); PG8_WAIT_L(0); PG8_BAR; PG8_MMA(1, 0, At, B0); PG8_MMA(1, 1, At, B1); PG8_BAR; PG8_SCHED;
            PG8_LDB(B0, 1, 0); PG8_LDB(B1, 1, 1); PG8_SCHED; PG8_LDA(At, 1, 0); PG8_STAGE(PG8_SA(0, 1), a2 + hstep, voffA);
            PG8_WAIT_V(8); PG8_WAIT_L(0); PG8_BAR; PG8_MMA(0, 0, At, B0); PG8_MMA(0, 1, At, B1); PG8_BAR; PG8_SCHED;
            PG8_LDA(At, 1, 1); PG8_STAGE(PG8_SB(1, 0), b3, voffB); PG8_STAGE(PG8_SB(1, 1), b3 + hstep, voffB); PG8_STAGE(PG8_SA(1, 0), a3, voffA);
            PG8_WAIT_V(8); PG8_WAIT_L(0); PG8_BAR; PG8_MMA(1, 0, At, B0); PG8_MMA(1, 1, At, B1); PG8_BAR; PG8_SCHED;
            } else {
            PG8_LDB(B0, 0, 0); PG8_SCHED; PG8_LDA(At, 0, 0); PG8_STAGE(PG8_SA(1, 1), a1 + hstep, voffA);
            PG8_WAIT_L(8); PG8_BAR; PG8_WAIT_L(0); PG8_MMA(0, 0, At, B0); PG8_BAR; PG8_SCHED;
            PG8_LDB(B1, 0, 1); PG8_STAGE(PG8_SB(0, 0), b2, voffB);
            PG8_BAR; PG8_WAIT_L(0); PG8_MMA(0, 1, At, B1); PG8_BAR;
            PG8_LDA(At, 0, 1); PG8_STAGE(PG8_SA(0, 0), a2, voffA);
            PG8_BAR; PG8_WAIT_L(0); PG8_MMA(1, 0, At, B0); PG8_BAR; PG8_SCHED;
            PG8_STAGE(PG8_SB(0, 1), b2 + hstep, voffB);
            PG8_WAIT_V(6); PG8_BAR; PG8_MMA(1, 1, At, B1); PG8_BAR;
            PG8_LDB(B0, 1, 0); PG8_SCHED; PG8_LDA(At, 1, 0); PG8_STAGE(PG8_SA(0, 1), a2 + hstep, voffA);
            PG8_WAIT_L(8); PG8_BAR; PG8_WAIT_L(0); PG8_MMA(0, 0, At, B0); PG8_BAR; PG8_SCHED;
            PG8_LDB(B1, 1, 1); PG8_STAGE(PG8_SB(1, 0), b3, voffB);
            PG8_BAR; PG8_WAIT_L(0); PG8_MMA(0, 1, At, B1); PG8_BAR;
            PG8_LDA(At, 1, 1); PG8_STAGE(PG8_SA(1, 0), a3, voffA);
            PG8_BAR; PG8_WAIT_L(0); PG8_MMA(1, 0, At, B0); PG8_BAR; PG8_SCHED;
            PG8_STAGE(PG8_SB(1, 1), b3 + hstep, voffB);
            PG8_WAIT_V(6); PG8_BAR; PG8_MMA(1, 1, At, B1); PG8_BAR;
            }
        }
        if constexpr (ALIGN_EPI) { if (wr == 0) PG8_BAR; }
        if constexpr (!Epi::AFTER_DRAIN) { E(acc, cur, wr, wc, fr, fq); S.done(cur); }
        if (!has_next) break;
#pragma unroll
        for (int a = 0; a < 2; ++a)
#pragma unroll
            for (int b = 0; b < 2; ++b)
#pragma unroll
                for (int m = 0; m < 4; ++m)
#pragma unroll
                    for (int n = 0; n < 2; ++n) acc[a][b][m][n] = (f32x4){0.f, 0.f, 0.f, 0.f};
        cur = nxt; cA = nA; cB = nB; ++ui;
        if constexpr (ALIGN_EPI) { if (wr == 1) PG8_BAR; }
    }
    PG8_WAIT_V(0);
    if constexpr (!ALIGN_EPI) { if (wr == 0) PG8_BAR; }
    PG8_BAR;
    if constexpr (Epi::AFTER_DRAIN) { E.fused(acc, cur, wr, wc, fr, fq, lds, wid, lane); S.done(cur); }
#undef PG8_SA
#undef PG8_SB
#undef PG8_STAGE
#undef PG8_LDA
#undef PG8_LDB
#undef PG8_MMA
#undef PG8_WAIT_V
#undef PG8_WAIT_L
#undef PG8_BAR
#undef PG8_SCHED
}
}

#ifndef KVGPR
#define KVGPR
#endif
constexpr int NWAVES = 8;
constexpr int N_LAUNCHES = MK_N_LAUNCHES;
constexpr int N_PHASES = 9;
constexpr int BATCH = 2, SEQ = 4096, DM = 2048, MROWS = BATCH * SEQ;
constexpr int MEMLEN = 256, MEMROWS = BATCH * MEMLEN;
constexpr int NQKG = 6144;
constexpr int NVT = 2048;
constexpr int MEMW = 512;
constexpr float EPS = 1e-6f;
constexpr float LOG2E = 1.4426950408889634f;
constexpr size_t MiB = 1u << 20;
constexpr size_t WS_CTL = 0, CTL_ZERO_BYTES = 64 * 1024;
constexpr size_t WS_WTIN = 1 * MiB;
constexpr size_t WS_WTOUT = 33 * MiB;
constexpr size_t WS_WTQ = 41 * MiB;
constexpr size_t WS_WTKV = 43 * MiB;
constexpr size_t WS_WTO = 47 * MiB;
constexpr size_t WS_XB = 49 * MiB;
constexpr size_t WS_MEMB = 81 * MiB;
constexpr size_t WS_KMEAN = 83 * MiB;
constexpr size_t WS_PART1 = 84 * MiB;
constexpr size_t WS_PART2 = 85 * MiB;
constexpr size_t WS_QKG = 86 * MiB;
constexpr size_t WS_VT = 182 * MiB;
constexpr size_t WS_Y = 214 * MiB;
constexpr size_t WS_X1 = 86 * MiB;
constexpr size_t WS_X1B = 150 * MiB;
constexpr size_t WS_QM = 182 * MiB;
constexpr size_t WS_KMEM = 190 * MiB;
constexpr size_t WS_VMEMT = 191 * MiB;
constexpr size_t WS_OM = 192 * MiB;
constexpr size_t WS_END = 256 * MiB;
constexpr int CW_QUEUE = 16;
constexpr int CW_BAR = 4096;
constexpr int LDS_BYTES = 147456;
constexpr int XCH_OFF = 65536;
constexpr int MISC_OFF = 131072;

#define LAS __attribute__((address_space(3)))
typedef unsigned short bf16_t;
typedef float f32x4 __attribute__((ext_vector_type(4)));
typedef float f32x16 __attribute__((ext_vector_type(16)));
typedef short bf16x8 __attribute__((ext_vector_type(8)));
typedef unsigned u32x4 __attribute__((ext_vector_type(4)));
typedef unsigned u32x2 __attribute__((ext_vector_type(2)));
typedef float f32x2_t __attribute__((ext_vector_type(2)));
typedef __bf16 bf16x2_t __attribute__((ext_vector_type(2)));

__device__ __forceinline__ unsigned pk2(float lo, float hi) { f32x2_t v = {lo, hi}; bf16x2_t b = __builtin_convertvector(v, bf16x2_t); return __builtin_bit_cast(unsigned, b); }
__device__ __forceinline__ float bf_lo(unsigned w) { return __uint_as_float(w << 16); }
__device__ __forceinline__ float bf_hi(unsigned w) { return __uint_as_float(w & 0xffff0000u); }
__device__ __forceinline__ float xsum32(float x) { const auto r = __builtin_amdgcn_permlane32_swap(__float_as_uint(x), __float_as_uint(x), false, false); return __uint_as_float(r[0]) + __uint_as_float(r[1]); }
__device__ __forceinline__ float xsum16(float x) { const auto r = __builtin_amdgcn_permlane16_swap(__float_as_uint(x), __float_as_uint(x), false, false); return __uint_as_float(r[0]) + __uint_as_float(r[1]); }
__device__ __forceinline__ float xmax32(float x) { const auto r = __builtin_amdgcn_permlane32_swap(__float_as_uint(x), __float_as_uint(x), false, false); return fmaxf(__uint_as_float(r[0]), __uint_as_float(r[1])); }
__device__ __forceinline__ unsigned xor32_u(unsigned x) { const auto r = __builtin_amdgcn_permlane32_swap(x, x, false, false); return r[0] | r[1]; }
__device__ __forceinline__ unsigned xor16_u(unsigned x) { const auto r = __builtin_amdgcn_permlane16_swap(x, x, false, false); return r[0] | r[1]; }
template <int CTRL> __device__ __forceinline__ unsigned dpp_u(unsigned x) { return (unsigned)__builtin_amdgcn_update_dpp(0, (int)x, CTRL, 0xf, 0xf, false); }
template <int CTRL> __device__ __forceinline__ float dpp_f(float x) { return __uint_as_float(dpp_u<CTRL>(__float_as_uint(x))); }
__device__ __forceinline__ float wave_sum(float v) {
    v += dpp_f<0xB1>(v); v += dpp_f<0x4E>(v); v += dpp_f<0x141>(v); v += dpp_f<0x140>(v);
    return xsum32(xsum16(v));
}
__device__ __forceinline__ unsigned wave_or(unsigned v) {
    v |= dpp_u<0xB1>(v); v |= dpp_u<0x4E>(v); v |= dpp_u<0x141>(v); v |= dpp_u<0x140>(v);
    return xor32_u(xor16_u(v));
}
__device__ __forceinline__ float silu_f(float x) { return x * __builtin_amdgcn_rcpf(1.0f + __builtin_amdgcn_exp2f(-x * LOG2E)); }

#define XB_TMO      128
#define XB_XCNT(j)  (256  + 64 * (j))
#define XB_XSUB(j)  (1280 + 64 * (j))
#define XB_XGEN(j)  (2304 + 64 * (j))
#define XB_TOP      3328
#define XB_TOPGEN   3392
#define XCD_BAR_WORDS 3456
#define XB_SPIN_CAP (1u << 18)

__device__ __forceinline__ unsigned xb_ld(unsigned* p)              { return __hip_atomic_load(p, __ATOMIC_RELAXED, __HIP_MEMORY_SCOPE_AGENT); }
__device__ __forceinline__ unsigned xb_add(unsigned* p, unsigned v) { return __hip_atomic_fetch_add(p, v, __ATOMIC_RELAXED, __HIP_MEMORY_SCOPE_AGENT); }
__device__ __forceinline__ unsigned xb_xcc_id() { return (unsigned)__builtin_amdgcn_s_getreg((3 << 11) | 20) & 0xFu; }
#define XB_SPIN(cond, bar) do { unsigned _sp = 0; while (cond) { __builtin_amdgcn_s_sleep(1); \
    if ((++_sp & 255u) == 0u) { if (xb_ld(&(bar)[XB_TMO])) break; if (_sp > XB_SPIN_CAP) { atomicAdd(&(bar)[XB_TMO], 1u); break; } } } } while (0)

struct XcdBarrier {
    unsigned* bar; unsigned x;
    volatile LAS unsigned* st;
};

__device__ __forceinline__ XcdBarrier xcd_barrier_post(unsigned* bar, volatile LAS unsigned* st, bool leader) {
    XcdBarrier b; b.bar = bar; b.x = xb_xcc_id(); b.st = st;
    if (leader) (void)xb_add(&bar[XB_XCNT(b.x)], 1u);
    return b;
}
__device__ __forceinline__ void xcd_barrier_complete(unsigned* bar, unsigned x, unsigned& nloc, unsigned& nx) {
    const unsigned G = gridDim.x * gridDim.y * gridDim.z;
    unsigned sum, cnt, mine, sp = 0u;
    for (;;) {
        sum = 0u; cnt = 0u; mine = 0u;
#pragma unroll
        for (unsigned j = 0; j < 16; ++j) { const unsigned c = xb_ld(&bar[XB_XCNT(j)]); sum += c; cnt += (c > 0u) ? 1u : 0u; mine = (j == x) ? c : mine; }
        if (sum == G) break;
        __builtin_amdgcn_s_sleep(1);
        if ((++sp & 255u) == 0u) { if (xb_ld(&bar[XB_TMO])) break; if (sp > XB_SPIN_CAP) { atomicAdd(&bar[XB_TMO], 1u); break; } }
    }
    nloc = mine > 0u ? mine : 1u; nx = cnt > 0u ? cnt : 1u;
}

__device__ __forceinline__ void xcd_barrier(const XcdBarrier& b, bool leader) {
    asm volatile("s_waitcnt vmcnt(0)" ::: "memory");
    __syncthreads();
    if (leader) {
        unsigned* bar = b.bar;
        __builtin_amdgcn_s_waitcnt(0);
        unsigned nloc = b.st[0], nx = b.st[1];
        if (nloc == 0u) { xcd_barrier_complete(bar, b.x, nloc, nx); b.st[0] = nloc; b.st[1] = nx; }
        const unsigned old = xb_add(&bar[XB_XSUB(b.x)], 1u);
        const unsigned gen = old / nloc;
        if (old + 1u == (gen + 1u) * nloc) {
            __builtin_amdgcn_fence(__ATOMIC_RELEASE, "agent");
            asm volatile("s_waitcnt vmcnt(0)" ::: "memory");
            const unsigned og = xb_add(&bar[XB_TOP], 1u);
            const unsigned tg = og / nx;
            if (og + 1u == (tg + 1u) * nx) xb_add(&bar[XB_TOPGEN], 1u);
            else XB_SPIN(xb_ld(&bar[XB_TOPGEN]) == tg, bar);
            __builtin_amdgcn_fence(__ATOMIC_ACQUIRE, "agent");
            xb_add(&bar[XB_XGEN(b.x)], 1u);
            asm volatile("s_waitcnt vmcnt(0)" ::: "memory");
        } else {
            XB_SPIN(xb_ld(&bar[XB_XGEN(b.x)]) == gen, bar);
            __builtin_amdgcn_fence(__ATOMIC_ACQUIRE, "agent");
            asm volatile("s_waitcnt vmcnt(0)" ::: "memory");
        }
    }
    __syncthreads();
}

struct Args {
    const float* in[16]; float* out; unsigned char* ws; int ph_lo, ph_hi;
};
typedef const __attribute__((address_space(4))) char* kargp_t;
__device__ __forceinline__ kargp_t kargs_() { kargp_t p = (kargp_t)__builtin_amdgcn_kernarg_segment_ptr(); asm volatile("" : "+s"(p)); return p; }
#define ARG_IN(k) (*(const float* const __attribute__((address_space(4)))*)(kargs_() + 8 * (k)))
#define ARG_OUT() (*(float* const __attribute__((address_space(4)))*)(kargs_() + 128))
#define ARG_WS() (*(unsigned char* const __attribute__((address_space(4)))*)(kargs_() + 136))
__device__ __forceinline__ int fresh_lane() { unsigned z = 0u; asm volatile("" : "+v"(z)); return (int)__builtin_amdgcn_mbcnt_hi(~0u, __builtin_amdgcn_mbcnt_lo(~0u, z)); }

__device__ __forceinline__ void p0_transpose_item(const float* W, int K, int N, const float* g, bf16_t* WT, int dst_row0, LAS float* scr, int k0, int n0, int lane) {
#pragma unroll 8
    for (int i = 0; i < 32; ++i) { const int kk = 2 * i + (lane >> 5); scr[kk * 33 + (lane & 31)] = W[(size_t)(k0 + kk) * N + n0 + (lane & 31)]; }
    asm volatile("s_waitcnt lgkmcnt(0)" ::: "memory");
    const int c = lane & 7;
    f32x4 ga = {1.f, 1.f, 1.f, 1.f}, gb = {1.f, 1.f, 1.f, 1.f};
    if (g) { ga = *(const f32x4*)(g + k0 + 8 * c); gb = *(const f32x4*)(g + k0 + 8 * c + 4); }
#pragma unroll
    for (int j = 0; j < 4; ++j) { const int n = (lane >> 3) + 8 * j; const LAS float* s = scr + (8 * c) * 33 + n;
        u32x4 o; o.x = pk2(s[0 * 33] * ga[0], s[1 * 33] * ga[1]); o.y = pk2(s[2 * 33] * ga[2], s[3 * 33] * ga[3]); o.z = pk2(s[4 * 33] * gb[0], s[5 * 33] * gb[1]); o.w = pk2(s[6 * 33] * gb[2], s[7 * 33] * gb[3]);
        *(u32x4*)(WT + (size_t)(dst_row0 + n) * K + k0 + 8 * c) = o; }
    asm volatile("s_waitcnt lgkmcnt(0)" ::: "memory");
}
__device__ __forceinline__ int win_dst_row(int n) {
    const int seg = n >> 10, o = n & 1023;
    switch (seg) { case 0: return o; case 1: return 1024 + o; case 2: return 6144 + o; case 3: return 2048 + o; case 4: return 3072 + o; case 5: return 7168 + o; default: return 4096 + (n - 6144); }
}
__device__ __forceinline__ void norm_row_to_bf16(const float* xrow, bf16_t* orow, int lane) {
    const f32x4* xr = (const f32x4*)xrow + lane;
    f32x4 v[8]; float s = 0.f;
#pragma unroll
    for (int j = 0; j < 8; ++j) { v[j] = xr[64 * j]; s += (v[j][0] * v[j][0] + v[j][1] * v[j][1]) + (v[j][2] * v[j][2] + v[j][3] * v[j][3]); }
    const float r = 1.0f / sqrtf(wave_sum(s) * (1.0f / DM) + EPS);
    u32x2* o8 = (u32x2*)orow + lane;
#pragma unroll
    for (int j = 0; j < 8; ++j) { u32x2 w; w.x = pk2(v[j][0] * r, v[j][1] * r); w.y = pk2(v[j][2] * r, v[j][3] * r); o8[64 * j] = w; }
}
__device__ __forceinline__ void p0_prologue(LAS unsigned char* lds, int wave) {
    const int lane = fresh_lane();
    unsigned char* ws = ARG_WS();
    LAS float* scr = (LAS float*)(lds + wave * 16384);
    const int gw = blockIdx.x * NWAVES + wave, NGW = gridDim.x * NWAVES;
    constexpr int I_IN = 32 * 256, I_OUT = 32 * 64, I_Q = 32 * 16, I_KV = 32 * 32, I_O = 8 * 64, NITEMS = I_IN + I_OUT + I_Q + I_KV + I_O;
    for (int it = gw; it < NITEMS; it += NGW) {
        int r = it;
        if (r < I_IN) { const int kb = r >> 8, nb = r & 255; p0_transpose_item(ARG_IN(3), DM, 8192, ARG_IN(2), (bf16_t*)(ws + WS_WTIN), win_dst_row(32 * nb), scr, 64 * kb, 32 * nb, lane); continue; } r -= I_IN;
        if (r < I_OUT) { const int kb = r >> 6, nb = r & 63; p0_transpose_item(ARG_IN(9), DM, DM, nullptr, (bf16_t*)(ws + WS_WTOUT), 32 * nb, scr, 64 * kb, 32 * nb, lane); continue; } r -= I_OUT;
        if (r < I_Q) { const int kb = r >> 4, nb = r & 15; p0_transpose_item(ARG_IN(12), DM, MEMW, ARG_IN(10), (bf16_t*)(ws + WS_WTQ), 32 * nb, scr, 64 * kb, 32 * nb, lane); continue; } r -= I_Q;
        if (r < I_KV) { const int kb = r >> 5, nb = r & 31; p0_transpose_item(ARG_IN(13), DM, 2 * MEMW, ARG_IN(11), (bf16_t*)(ws + WS_WTKV), 32 * nb, scr, 64 * kb, 32 * nb, lane); continue; } r -= I_KV;
        { const int kb = r >> 6, nb = r & 63; p0_transpose_item(ARG_IN(14), MEMW, DM, nullptr, (bf16_t*)(ws + WS_WTO), 32 * nb, scr, 64 * kb, 32 * nb, lane); }
    }
    for (int m = gw; m < MROWS + MEMROWS; m += NGW) {
        if (m < MROWS) norm_row_to_bf16(ARG_IN(0) + (size_t)m * DM, (bf16_t*)(ws + WS_XB) + (size_t)m * DM, lane);
        else norm_row_to_bf16(ARG_IN(1) + (size_t)(m - MROWS) * DM, (bf16_t*)(ws + WS_MEMB) + (size_t)(m - MROWS) * DM, lane);
    }
}

__device__ __forceinline__ void p2_kmean(LAS unsigned char* lds, int wave) {
    const int lane = fresh_lane(), tid = wave * 64 + lane;
    const bf16_t* qkg = (const bf16_t*)(ARG_WS() + WS_QKG); float* kmean = (float*)(ARG_WS() + WS_KMEAN);
    LAS float* red = (LAS float*)lds;
    for (int it = blockIdx.x; it < BATCH * 8 * 16; it += gridDim.x) {
        const int n = it & 15, h = (it >> 4) & 7, b = it >> 7;
        const bf16_t* src = qkg + (size_t)(b * SEQ + n * 256 + wave * 32) * NQKG + 3072 + h * 128 + 2 * lane;
        float s0 = 0.f, s1 = 0.f;
#pragma unroll 8
        for (int k = 0; k < 32; ++k) { const unsigned w = *(const unsigned*)(src + (size_t)k * NQKG); s0 += bf_lo(w); s1 += bf_hi(w); }
        red[wave * 128 + 2 * lane] = s0; red[wave * 128 + 2 * lane + 1] = s1;
        __syncthreads();
        if (tid < 128) { float s = 0.f;
#pragma unroll
            for (int w = 0; w < 8; ++w) s += red[w * 128 + tid];
            kmean[(size_t)it * 128 + tid] = s * (1.0f / 256.0f); }
        __syncthreads();
    }
}

struct AttnArgs {
    const bf16_t* qkg; const bf16_t* vt; const float* kmean; bf16_t* y;
    const bf16_t* qm; const bf16_t* kmem; const bf16_t* vmemt; bf16_t* om;
    const float* subln_g; float lam;
};
__device__ __forceinline__ int kperm(int i) { return (i & 0x13) | ((i & 4) << 1) | ((i & 8) >> 1); }
#if 1
__device__ __forceinline__ float max3f(float a, float b, float c) { return fmaxf(fmaxf(a, b), c); }
__device__ __forceinline__ float max2f(float a, float b) { return fmaxf(a, b); }
__device__ __forceinline__ float fadd_s(float a, float b) { return a + b; }
#else
__device__ __forceinline__ float max3f(float a, float b, float c) { float r; asm("v_max3_f32 %0, %1, %2, %3" : "=v"(r) : "v"(a), "v"(b), "v"(c)); return r; }
__device__ __forceinline__ float max2f(float a, float b) { float r; asm("v_max_f32_e32 %0, %1, %2" : "=v"(r) : "v"(a), "v"(b)); return r; }
__device__ __forceinline__ float fadd_s(float a, float b) { float r; asm("v_add_f32_e32 %0, %1, %2" : "=v"(r) : "v"(a), "v"(b)); return r; }
#endif
#define ATT_THR 8.0f
#define ATT_SBAR() __builtin_amdgcn_sched_barrier(0)

template <int MODE>
__device__ __forceinline__ void attn_unit(LAS unsigned char* lds, const AttnArgs& A, int b, int h, int ui, int wid, int lane_in) {
    int lane = lane_in; asm volatile("" : "+v"(lane));
    constexpr int NKS = (MODE == 0) ? 4 : 8;
    const float NEG_INF = -__builtin_inff();
    const int tid = wid * 64 + lane, i32 = lane & 31, hi = lane >> 5;
    const int comp = (MODE == 0) ? (wid >> 2) : 0, qb = (MODE == 0) ? (wid & 3) : wid;
    const int q0 = (MODE == 0) ? ui * 128 : ui * 256;
    const int q0w = q0 + 32 * qb;
    const int qpos = q0w + i32;
    const size_t tok = (size_t)b * SEQ + qpos;
    const bf16_t *Qg, *Kg, *Vg; int kp, vp;
    if (MODE == 0) { Qg = A.qkg + tok * NQKG + h * 128 + comp * 64; Kg = A.qkg + (size_t)(b * SEQ) * NQKG + 1024 + h * 128; kp = NQKG; Vg = A.vt + (size_t)(h * 128) * MROWS + b * SEQ; vp = MROWS; }
    else if (MODE == 1) { Qg = A.qkg + tok * NQKG + 2048 + h * 128; Kg = A.qkg + (size_t)(b * SEQ) * NQKG + 3072 + h * 128; kp = NQKG; Vg = A.vt + (size_t)(1024 + h * 128) * MROWS + b * SEQ; vp = MROWS; }
    else { Qg = A.qm + tok * MEMW + h * 128; Kg = A.kmem + (size_t)(b * MEMLEN) * MEMW + h * 128; kp = MEMW; Vg = A.vmemt + (size_t)(h * 128) * MEMROWS + b * MEMLEN; vp = MEMROWS; }
    bf16x8 qf[NKS];
#pragma unroll
    for (int ks = 0; ks < NKS; ++ks) qf[ks] = *(const bf16x8*)(Qg + ks * 16 + hi * 8);
    const float slope2 = (MODE == 2) ? 0.f : LOG2E / (float)(1 << (h + 1));

    unsigned sel = 0u, wsel = 0u; unsigned long long tmask;
    if (MODE == 0) { const int nt = 2 * (ui + 1); tmask = (nt >= 64) ? ~0ull : ((1ull << nt) - 1ull); }
    else if (MODE == 2) tmask = 0xFull;
    else {
        const int c = ui;
        LAS float* km = (LAS float*)(lds + MISC_OFF + 1024);
        LAS unsigned* wm = (LAS unsigned*)(lds + MISC_OFF + 64);
        if (c > 0) {
            *(LAS f32x4*)(km + tid * 4) = *(const f32x4*)(A.kmean + (size_t)((b * 8 + h) * 16) * 128 + tid * 4);
            __syncthreads();
            float sc[16];
#pragma unroll
            for (int n = 0; n < 16; ++n) { sc[n] = NEG_INF;
                if (n < c) { float acc = 0.f;
#pragma unroll
                    for (int ks = 0; ks < NKS; ++ks) { const f32x4 k0 = *(const LAS f32x4*)(km + n * 128 + ks * 16 + hi * 8), k1 = *(const LAS f32x4*)(km + n * 128 + ks * 16 + hi * 8 + 4);
#pragma unroll
                        for (int e = 0; e < 4; ++e) { acc = fmaf(__uint_as_float((unsigned)(unsigned short)qf[ks][e] << 16), k0[e], acc); acc = fmaf(__uint_as_float((unsigned)(unsigned short)qf[ks][4 + e] << 16), k1[e], acc); } }
                    sc[n] = xsum32(acc); } }
#pragma unroll
            for (int k = 0; k < 3; ++k) { float best = NEG_INF; int bi = -1;
#pragma unroll
                for (int n = 0; n < 16; ++n) { const bool ok = (n < c) && !((sel >> n) & 1u) && (sc[n] > best); best = ok ? sc[n] : best; bi = ok ? n : bi; }
                if (bi >= 0) sel |= 1u << bi; }
            wsel = __builtin_amdgcn_readfirstlane(wave_or(sel));
        }
        if (lane == 0) wm[wid] = wsel;
        __syncthreads();
        unsigned bm = 1u << c;
#pragma unroll
        for (int w = 0; w < 8; ++w) bm |= wm[w];
        bm = __builtin_amdgcn_readfirstlane(bm);
        tmask = 0ull;
#pragma unroll
        for (int n = 0; n < 16; ++n) if ((bm >> n) & 1u) tmask |= 0xFull << (4 * n);
    }

    const int qaddr = XCH_OFF + wid * 8192 + lane * 16;
#pragma unroll
    for (int ks = 0; ks < NKS; ++ks) *(LAS bf16x8*)(lds + qaddr + ks * 1024) = qf[ks];
    const int kpi = kperm(i32), kx = kpi & 15;
    const int kbase = kpi * 256 + ((((MODE == 0 ? comp * 8 : 0) + hi) ^ kx) << 4);
    const int vbase = i32 * 128 + ((hi ^ ((i32 >> 1) & 7)) << 4);
    unsigned ksoff[2], vsoff[2];
#pragma unroll
    for (int j = 0; j < 2; ++j) {
        const int kr = 8 * wid + 4 * j + (lane >> 4), kc = (lane & 15) ^ (kr & 15);
        ksoff[j] = (unsigned)((kr * kp + kc * 8) * 2);
        const int vr = 16 * wid + 8 * j + (lane >> 3), vc = (lane & 7) ^ ((vr >> 1) & 7);
        vsoff[j] = (unsigned)((vr * vp + vc * 8) * 2);
    }
    const unsigned kdst = (unsigned)(8 * wid) * 256u, vdst = (unsigned)(16 * wid) * 128u;
#define ATT_DMA_K(t, buf) do { const char* g_ = (const char*)Kg + (size_t)(64 * (t)) * kp * 2; \
        __builtin_amdgcn_global_load_lds((const unsigned*)(g_ + ksoff[0]), (LAS unsigned*)(lds + (buf) * 16384 + kdst), 16, 0, 0); \
        __builtin_amdgcn_global_load_lds((const unsigned*)(g_ + ksoff[1]), (LAS unsigned*)(lds + (buf) * 16384 + kdst + 1024), 16, 0, 0); } while (0)
#define ATT_DMA_V(t, buf) do { const char* g_ = (const char*)Vg + (size_t)(64 * (t)) * 2; \
        __builtin_amdgcn_global_load_lds((const unsigned*)(g_ + vsoff[0]), (LAS unsigned*)(lds + (buf) * 16384 + vdst), 16, 0, 0); \
        __builtin_amdgcn_global_load_lds((const unsigned*)(g_ + vsoff[1]), (LAS unsigned*)(lds + (buf) * 16384 + vdst + 1024), 16, 0, 0); } while (0)

    f32x16 O[4];
#pragma unroll
    for (int dt = 0; dt < 4; ++dt)
#pragma unroll
        for (int r = 0; r < 16; ++r) O[dt][r] = 0.f;
    float m_ref = 0.f, l_run = 0.f;
    asm volatile("" : "+v"(m_ref));
    f32x16 S0, S1;
    u32x4 pw[4];

#define ATT_TB(t, out) do { if (MODE == 2) out = -m_ref; else { const int rel_ = 64 * (t) + 8 * hi - qpos; bool dead_ = false; \
        if (MODE == 1) { const int n_ = (t) >> 2; dead_ = ((t) >= 0) && (n_ < ui) && !((sel >> n_) & 1u); } \
        out = dead_ ? NEG_INF : fmaf(slope2, (float)rel_, -m_ref); } } while (0)
#define ATT_INIT_Q(q, t, tb_, MASKED) do { const int r0 = 8 * ((q) & 1); const int rel_ = 64 * (t) + 8 * hi - qpos; \
        float v_ = (MODE == 2) ? (tb_) : ((tb_) + slope2 * (float)((((q) < 2) ? 0 : 32) + 16 * ((q) & 1))); \
        _Pragma("unroll") for (int r = r0; r < r0 + 8; ++r) { const int ko_ = (((q) < 2) ? 0 : 32) + (r & 7) + 16 * (r >> 3); \
            float w_ = v_; if ((MASKED) && MODE != 2) w_ = (rel_ + ko_ > 0) ? NEG_INF : w_; \
            if ((q) < 2) S0[r] = w_; else S1[r] = w_; \
            if (MODE != 2) v_ = v_ + slope2; } } while (0)
#define ATT_QK_SEG(kbuf, ks0, n) do { const LAS unsigned char* kb_ = lds + (kbuf) * 16384; int kb0_ = kbase; asm volatile("" : "+v"(kb0_)); \
        _Pragma("unroll") for (int ks = (ks0); ks < (ks0) + (n); ++ks) { const int ka_ = kb0_ ^ (ks << 5); \
            const bf16x8 k0_ = *(const LAS bf16x8*)(kb_ + ka_), k1_ = *(const LAS bf16x8*)(kb_ + ka_ + 8192); \
            const bf16x8 q_ = *(const LAS bf16x8*)(lds + qaddr + ks * 1024); \
            S0 = __builtin_amdgcn_mfma_f32_32x32x16_bf16(k0_, q_, S0, 0, 0, 0); S1 = __builtin_amdgcn_mfma_f32_32x32x16_bf16(k1_, q_, S1, 0, 0, 0); } } while (0)
#define ATT_QK(kbuf) do { if (NKS == 4) { ATT_QK_SEG(kbuf, 0, 4); } else { ATT_QK_SEG(kbuf, 0, 4); ATT_SBAR(); ATT_QK_SEG(kbuf, 4, 4); } ATT_SBAR(); } while (0)
#define ATT_ESP_Q(q) do { const int r0 = 8 * ((q) & 1); \
        if ((q) < 2) { _Pragma("unroll") for (int r = r0; r < r0 + 8; ++r) S0[r] = __builtin_amdgcn_exp2f(S0[r]); \
            l_run = fadd_s(l_run, fadd_s(fadd_s(fadd_s(S0[r0], S0[r0 + 1]), fadd_s(S0[r0 + 2], S0[r0 + 3])), fadd_s(fadd_s(S0[r0 + 4], S0[r0 + 5]), fadd_s(S0[r0 + 6], S0[r0 + 7])))); \
            pw[q].x = pk2(S0[r0], S0[r0 + 1]); pw[q].y = pk2(S0[r0 + 2], S0[r0 + 3]); pw[q].z = pk2(S0[r0 + 4], S0[r0 + 5]); pw[q].w = pk2(S0[r0 + 6], S0[r0 + 7]); } \
        else { _Pragma("unroll") for (int r = r0; r < r0 + 8; ++r) S1[r] = __builtin_amdgcn_exp2f(S1[r]); \
            l_run = fadd_s(l_run, fadd_s(fadd_s(fadd_s(S1[r0], S1[r0 + 1]), fadd_s(S1[r0 + 2], S1[r0 + 3])), fadd_s(fadd_s(S1[r0 + 4], S1[r0 + 5]), fadd_s(S1[r0 + 6], S1[r0 + 7])))); \
            pw[q].x = pk2(S1[r0], S1[r0 + 1]); pw[q].y = pk2(S1[r0 + 2], S1[r0 + 3]); pw[q].z = pk2(S1[r0 + 4], S1[r0 + 5]); pw[q].w = pk2(S1[r0 + 6], S1[r0 + 7]); } } while (0)
#define ATT_PV_SEG(vbuf, s) do { const LAS unsigned char* vb_ = lds + (vbuf) * 16384; const bf16x8 p_ = __builtin_bit_cast(bf16x8, pw[s]); \
        int vb0_ = vbase; asm volatile("" : "+v"(vb0_)); const int va_ = vb0_ ^ ((s) << 5); \
        _Pragma("unroll") for (int dt = 0; dt < 4; ++dt) { \
            const bf16x8 v_ = *(const LAS bf16x8*)(vb_ + va_ + dt * 4096); \
            O[dt] = __builtin_amdgcn_mfma_f32_32x32x16_bf16(v_, p_, O[dt], 0, 0, 0); } } while (0)
#define ATT_ROWMAX(mx) do { \
        float a_ = max3f(S0[0], S0[1], S1[0]), b_ = max3f(S0[2], S0[3], S1[1]); a_ = max3f(a_, S1[2], S1[3]); \
        _Pragma("unroll") for (int r = 4; r < 16; r += 4) { a_ = max3f(a_, S0[r], S0[r + 1]); b_ = max3f(b_, S0[r + 2], S0[r + 3]); a_ = max3f(a_, S1[r], S1[r + 1]); b_ = max3f(b_, S1[r + 2], S1[r + 3]); } \
        mx = xmax32(max2f(a_, b_)); } while (0)
#define ATT_RESCALE_PW(f_) do { _Pragma("unroll") for (int s = 0; s < 4; ++s) { \
        pw[s].x = pk2(bf_lo(pw[s].x) * (f_), bf_hi(pw[s].x) * (f_)); pw[s].y = pk2(bf_lo(pw[s].y) * (f_), bf_hi(pw[s].y) * (f_)); \
        pw[s].z = pk2(bf_lo(pw[s].z) * (f_), bf_hi(pw[s].z) * (f_)); pw[s].w = pk2(bf_lo(pw[s].w) * (f_), bf_hi(pw[s].w) * (f_)); } } while (0)
#define ATT_STEP(t, tn, kbuf, vbuf, MASKED) do { \
        ATT_QK(kbuf); \
        float mx_; ATT_ROWMAX(mx_); \
        if (__builtin_expect(__any(mx_ > ATT_THR), 0)) { \
            const float d_ = fmaxf(mx_, 0.f), f_ = __builtin_amdgcn_exp2f(-d_); m_ref += d_; l_run *= f_; \
            _Pragma("unroll") for (int dt = 0; dt < 4; ++dt) _Pragma("unroll") for (int r = 0; r < 16; ++r) O[dt][r] *= f_; \
            _Pragma("unroll") for (int r = 0; r < 16; ++r) { S0[r] -= d_; S1[r] -= d_; } \
            ATT_RESCALE_PW(f_); \
        } \
        float tbn_; ATT_TB((tn), tbn_); ATT_SBAR(); \
        ATT_PV_SEG(vbuf, 0); ATT_ESP_Q(0); ATT_INIT_Q(0, (tn), tbn_, MASKED); ATT_SBAR(); \
        ATT_PV_SEG(vbuf, 1); ATT_ESP_Q(1); ATT_INIT_Q(1, (tn), tbn_, MASKED); ATT_SBAR(); \
        ATT_PV_SEG(vbuf, 2); ATT_ESP_Q(2); ATT_INIT_Q(2, (tn), tbn_, MASKED); ATT_SBAR(); \
        ATT_PV_SEG(vbuf, 3); ATT_ESP_Q(3); ATT_INIT_Q(3, (tn), tbn_, MASKED); ATT_SBAR(); } while (0)
#define ATT_DRAIN(vbuf) do { ATT_PV_SEG(vbuf, 0); ATT_SBAR(); ATT_PV_SEG(vbuf, 1); ATT_SBAR(); ATT_PV_SEG(vbuf, 2); ATT_SBAR(); ATT_PV_SEG(vbuf, 3); } while (0)
#define ATT_POP(var) do { var = -1; if (rem) { var = 63 - __builtin_clzll(rem); rem &= ~(1ull << var); } } while (0)
#define ATT_ADVANCE() do { tcur = tnext; ATT_POP(tnext); } while (0)

    unsigned long long rem = tmask;
    int tcur, tnext; ATT_POP(tcur); ATT_POP(tnext);
    ATT_DMA_K(tcur, 0);
    { float tb0_; ATT_TB(tcur, tb0_); ATT_INIT_Q(0, tcur, tb0_, true); ATT_INIT_Q(1, tcur, tb0_, true); ATT_INIT_Q(2, tcur, tb0_, true); ATT_INIT_Q(3, tcur, tb0_, true); }
    __syncthreads();
    if (tnext >= 0) ATT_DMA_K(tnext, 1);
    ATT_DMA_V(tcur, 2);
    {
        ATT_QK(0);
        float mx_; ATT_ROWMAX(mx_);
        m_ref = fmaxf(mx_, -1000.0f);
#pragma unroll
        for (int r = 0; r < 16; ++r) { S0[r] -= m_ref; S1[r] -= m_ref; }
        float tbn_; ATT_TB(tnext, tbn_);
        ATT_ESP_Q(0); ATT_INIT_Q(0, tnext, tbn_, true); ATT_ESP_Q(1); ATT_INIT_Q(1, tnext, tbn_, true);
        ATT_ESP_Q(2); ATT_INIT_Q(2, tnext, tbn_, true); ATT_ESP_Q(3); ATT_INIT_Q(3, tnext, tbn_, true);
    }
    __syncthreads();
    ATT_ADVANCE();
    if (MODE == 1) {
        if (tnext >= 0) ATT_DMA_K(tnext, 0);
        ATT_DMA_V(tcur, 3);
        ATT_STEP(tcur, tnext, 1, 2, true);
        __syncthreads();
        ATT_ADVANCE();
        if (tnext >= 0) ATT_DMA_K(tnext, 1);
        ATT_DMA_V(tcur, 2);
        ATT_STEP(tcur, tnext, 0, 3, true);
        __syncthreads();
        ATT_ADVANCE();
    }
    for (;;) {
        if (tcur < 0) { ATT_DRAIN(2); break; }
        if (tnext >= 0) ATT_DMA_K(tnext, 0);
        ATT_DMA_V(tcur, 3);
        ATT_STEP(tcur, tnext, 1, 2, false);
        __syncthreads();
        ATT_ADVANCE();
        if (tcur < 0) { ATT_DRAIN(3); break; }
        if (tnext >= 0) ATT_DMA_K(tnext, 1);
        ATT_DMA_V(tcur, 2);
        ATT_STEP(tcur, tnext, 0, 3, false);
        __syncthreads();
        ATT_ADVANCE();
    }
    __syncthreads();
#undef ATT_DMA_K
#undef ATT_DMA_V
#undef ATT_TB
#undef ATT_INIT_Q
#undef ATT_QK_SEG
#undef ATT_QK
#undef ATT_ESP_Q
#undef ATT_PV_SEG
#undef ATT_ROWMAX
#undef ATT_RESCALE_PW
#undef ATT_STEP
#undef ATT_DRAIN
#undef ATT_POP
#undef ATT_ADVANCE

    const float lt = xsum32(l_run);
    const float linv = 1.0f / lt;
    if (MODE == 0) {
        LAS float* xch = (LAS float*)(lds + XCH_OFF);
        if (comp == 1) {
#pragma unroll
            for (int dt = 0; dt < 4; ++dt)
#pragma unroll
                for (int r = 0; r < 16; ++r) xch[(qb * 64 + dt * 16 + r) * 64 + lane] = O[dt][r] * linv;
        }
        __syncthreads();
        if (comp == 0) {
            float ss = 0.f;
#pragma unroll
            for (int dt = 0; dt < 4; ++dt)
#pragma unroll
                for (int r = 0; r < 16; ++r) { const float o2 = xch[(qb * 64 + dt * 16 + r) * 64 + lane]; const float o = O[dt][r] * linv - A.lam * o2; O[dt][r] = o; ss += o * o; }
            ss = xsum32(ss);
            const float rn = 0.8f / sqrtf(ss * (1.0f / 128.0f) + EPS);
            const bf16_t* gp = A.qkg + tok * NQKG + 4096 + h * 128; bf16_t* yp = A.y + tok * DM + h * 128;
#pragma unroll
            for (int dt = 0; dt < 4; ++dt)
#pragma unroll
                for (int g4 = 0; g4 < 4; ++g4) { const int d = 32 * dt + 8 * g4 + 4 * hi;
                    const f32x4 sg = *(const f32x4*)(A.subln_g + d); const u32x2 gw = *(const u32x2*)(gp + d);
                    const float o0 = O[dt][4 * g4 + 0] * rn * sg[0] * silu_f(bf_lo(gw.x)), o1 = O[dt][4 * g4 + 1] * rn * sg[1] * silu_f(bf_hi(gw.x));
                    const float o2 = O[dt][4 * g4 + 2] * rn * sg[2] * silu_f(bf_lo(gw.y)), o3 = O[dt][4 * g4 + 3] * rn * sg[3] * silu_f(bf_hi(gw.y));
                    u32x2 w; w.x = pk2(o0, o1); w.y = pk2(o2, o3); *(u32x2*)(yp + d) = w; }
        }
        __syncthreads();
    } else if (MODE == 1) {
        const bf16_t* gp = A.qkg + tok * NQKG + 4096 + 1024 + h * 128; bf16_t* yp = A.y + tok * DM + 1024 + h * 128;
#pragma unroll
        for (int dt = 0; dt < 4; ++dt)
#pragma unroll
            for (int g4 = 0; g4 < 4; ++g4) { const int d = 32 * dt + 8 * g4 + 4 * hi; const u32x2 gw = *(const u32x2*)(gp + d);
                const float o0 = O[dt][4 * g4 + 0] * linv * silu_f(bf_lo(gw.x)), o1 = O[dt][4 * g4 + 1] * linv * silu_f(bf_hi(gw.x));
                const float o2 = O[dt][4 * g4 + 2] * linv * silu_f(bf_lo(gw.y)), o3 = O[dt][4 * g4 + 3] * linv * silu_f(bf_hi(gw.y));
                u32x2 w; w.x = pk2(o0, o1); w.y = pk2(o2, o3); *(u32x2*)(yp + d) = w; }
    } else {
        bf16_t* op = A.om + tok * MEMW + h * 128;
#pragma unroll
        for (int dt = 0; dt < 4; ++dt)
#pragma unroll
            for (int g4 = 0; g4 < 4; ++g4) { const int d = 32 * dt + 8 * g4 + 4 * hi;
                u32x2 w; w.x = pk2(O[dt][4 * g4 + 0] * linv, O[dt][4 * g4 + 1] * linv); w.y = pk2(O[dt][4 * g4 + 2] * linv, O[dt][4 * g4 + 3] * linv); *(u32x2*)(op + d) = w; }
    }
}

__constant__ const unsigned short ATT_ORDER[48] = {271, 270, 269, 268, 31, 267, 30, 29, 266, 28, 27, 26, 265, 25, 24, 23, 264, 22, 21, 263, 20, 19, 18, 262, 17, 16, 15, 261, 14, 13, 260, 12, 11, 10, 259, 9, 8, 7, 258, 6, 5, 257, 4, 3, 2, 256, 1, 0};

__device__ __forceinline__ void p3_attention(LAS unsigned char* lds, int wave, int qsel) {
    const int lane = fresh_lane(), tid = wave * 64 + lane;
    AttnArgs A;
    A.qkg = (const bf16_t*)(ARG_WS() + WS_QKG); A.vt = (const bf16_t*)(ARG_WS() + WS_VT); A.kmean = (const float*)(ARG_WS() + WS_KMEAN); A.y = (bf16_t*)(ARG_WS() + WS_Y);
    A.qm = nullptr; A.kmem = nullptr; A.vmemt = nullptr; A.om = nullptr; A.subln_g = ARG_IN(8);
    { const float s1 = wave_sum(ARG_IN(4)[lane] * ARG_IN(5)[lane]), s2 = wave_sum(ARG_IN(6)[lane] * ARG_IN(7)[lane]); A.lam = expf(s1) - expf(s2) + 0.2f; }
    unsigned* qhead = (unsigned*)(ARG_WS() + WS_CTL) + CW_QUEUE + 64 * qsel;
    LAS unsigned* slot = (LAS unsigned*)(lds + MISC_OFF);
    for (;;) {
        if (tid == 0) slot[0] = atomicAdd(qhead, 1u);
        __syncthreads();
        const int item = __builtin_amdgcn_readfirstlane((int)slot[0]);
        __syncthreads();
        if (item >= 768) break;
        const int bh = item & 15, e = ATT_ORDER[item >> 4];
        const int b = bh >> 3, h = bh & 7, idx = e & 255;
        #if defined(T_ONLY0)
        attn_unit<0>(lds, A, b, h, idx, wave, lane);
#elif defined(T_ONLY1)
        attn_unit<1>(lds, A, b, h, idx & 15, wave, lane);
#else
        if (e >> 8) attn_unit<1>(lds, A, b, h, idx, wave, lane); else attn_unit<0>(lds, A, b, h, idx, wave, lane);
#endif
    }
}
__device__ __forceinline__ void p6_cross(LAS unsigned char* lds, int wave) {
    const int lane = fresh_lane();
    AttnArgs A;
    A.qkg = nullptr; A.vt = nullptr; A.kmean = nullptr; A.y = nullptr; A.subln_g = nullptr; A.lam = 0.f;
    A.qm = (const bf16_t*)(ARG_WS() + WS_QM); A.kmem = (const bf16_t*)(ARG_WS() + WS_KMEM); A.vmemt = (const bf16_t*)(ARG_WS() + WS_VMEMT); A.om = (bf16_t*)(ARG_WS() + WS_OM);
    for (int u = blockIdx.x; u < BATCH * 4 * 16; u += gridDim.x) attn_unit<2>(lds, A, u >> 6, (u >> 4) & 3, u & 15, wave, lane);
}

__device__ __forceinline__ void p8_final(int wave) {
    const int lane = fresh_lane();
    const float* part2 = (const float*)(ARG_WS() + WS_PART2); const float* g = ARG_IN(15);
    const int gw = blockIdx.x * NWAVES + wave, NGW = gridDim.x * NWAVES;
    for (int m = gw; m < MROWS; m += NGW) {
        const float p = (lane < 32) ? part2[(size_t)m * 32 + lane] : 0.f;
        const float r = 1.0f / sqrtf(wave_sum(p) * (1.0f / DM) + EPS);
        f32x4* o = (f32x4*)(ARG_OUT() + (size_t)m * DM) + lane; const f32x4* gg = (const f32x4*)g + lane;
#pragma unroll
        for (int j = 0; j < 8; ++j) { const f32x4 v = o[64 * j]; o[64 * j] = v * r * gg[64 * j]; }
    }
}

__global__ void __launch_bounds__(NWAVES * 64, 2) mega_fwd(Args a) {
    extern __shared__ __attribute__((aligned(16))) unsigned char lds_raw[];
    LAS unsigned char* lds = (LAS unsigned char*)lds_raw;
    const int wave = __builtin_amdgcn_readfirstlane((int)threadIdx.x >> 6);
    const int G = gridDim.x, bx = blockIdx.x;
    const int lo = a.ph_lo, hi = a.ph_hi;
#define ws ARG_WS()
#ifndef PHASE_MASK
#define PHASE_MASK 0x1ff
#endif
#define IN(k) (((PHASE_MASK >> (k)) & 1) && lo <= (k) && (k) < hi)
#define GRID_BAR(k) do { if (IN(k) && IN((k) + 1)) { xcd_barrier(bar, wave == 0 && fresh_lane() == 0); } } while (0)
    typedef pg8::bf16_t pbf;
    XcdBarrier bar; bar.bar = (unsigned*)(ARG_WS() + WS_CTL) + CW_BAR; bar.x = 0; bar.st = (volatile LAS unsigned*)(lds + MISC_OFF + 32);
    if (hi - lo > 1) {
        const bool leader0 = (wave == 0 && fresh_lane() == 0);
        if (leader0) { bar.st[0] = 0u; bar.st[1] = 0u; }
        __syncthreads();
        bar = xcd_barrier_post((unsigned*)(ARG_WS() + WS_CTL) + CW_BAR, (volatile LAS unsigned*)(lds + MISC_OFF + 32), leader0);
    }
    if (IN(0)) { p0_prologue(lds, wave); }
    GRID_BAR(0);
    if (IN(1)) {
        { pg8::Gemm g{(const pbf*)(ws + WS_XB), (const pbf*)(ws + WS_WTIN), MROWS, NQKG, DM}; pg8::StaticOrder S; S.init(MROWS, NQKG, G, bx);
          pg8::EpiScaleBf16 E{(pbf*)(ws + WS_QKG), NQKG, 0, 1024, 0.125f * LOG2E, 2048, 3072, 0.08838834764831845f * LOG2E};
          pg8::gemm_phase<pg8::EpiScaleBf16, pg8::StaticOrder, true, true>(lds, g, S, E, wave); }
        { pg8::Gemm g{(const pbf*)(ws + WS_WTIN) + (size_t)NQKG * DM, (const pbf*)(ws + WS_XB), NVT, MROWS, DM}; pg8::StaticOrder S; S.init(NVT, MROWS, G, bx);
          pg8::EpiScaleBf16 E{(pbf*)(ws + WS_VT), MROWS, 0, 0, 1.f, 0, 0, 1.f};
          pg8::gemm_phase<pg8::EpiScaleBf16, pg8::StaticOrder, true, true>(lds, g, S, E, wave); }
    }
    GRID_BAR(1);
    if (IN(2)) { p2_kmean(lds, wave); }
    GRID_BAR(2);
    if (IN(3)) { p3_attention(lds, wave, 0); }
    GRID_BAR(3);
    if (IN(4)) {
        pg8::Gemm g{(const pbf*)(ws + WS_Y), (const pbf*)(ws + WS_WTOUT), MROWS, DM, DM}; pg8::StaticOrder S; S.init(MROWS, DM, G, bx);
        pg8::EpiResid E{ARG_IN(0), (float*)(ws + WS_X1), (pbf*)(ws + WS_X1B), (float*)(ws + WS_PART1), DM};
        pg8::gemm_phase<pg8::EpiResid, pg8::StaticOrder, false, true>(lds, g, S, E, wave);
    }
    GRID_BAR(4);
    if (IN(5)) {
        { pg8::Gemm g{(const pbf*)(ws + WS_X1B), (const pbf*)(ws + WS_WTQ), MROWS, MEMW, DM}; pg8::StaticOrder S; S.init(MROWS, MEMW, G, bx);
          pg8::EpiRowNormBf16 E{(pbf*)(ws + WS_QM), MEMW, (const float*)(ws + WS_PART1), 0.08838834764831845f * LOG2E, 1.0f / DM, EPS};
          pg8::gemm_phase<pg8::EpiRowNormBf16, pg8::StaticOrder, false, true>(lds, g, S, E, wave); }
        { pg8::Gemm g{(const pbf*)(ws + WS_MEMB), (const pbf*)(ws + WS_WTKV), MEMROWS, MEMW, DM}; pg8::StaticOrder S; S.init(MEMROWS, MEMW, G, (bx + G - 64) % G);
          pg8::EpiScaleBf16 E{(pbf*)(ws + WS_KMEM), MEMW, 0, 0, 1.f, 0, 0, 1.f};
          pg8::gemm_phase<pg8::EpiScaleBf16, pg8::StaticOrder, false, true>(lds, g, S, E, wave); }
        { pg8::Gemm g{(const pbf*)(ws + WS_WTKV) + (size_t)MEMW * DM, (const pbf*)(ws + WS_MEMB), MEMW, MEMROWS, DM}; pg8::StaticOrder S; S.init(MEMW, MEMROWS, G, (bx + G - 68) % G);
          pg8::EpiScaleBf16 E{(pbf*)(ws + WS_VMEMT), MEMROWS, 0, 0, 1.f, 0, 0, 1.f};
          pg8::gemm_phase<pg8::EpiScaleBf16, pg8::StaticOrder, false, true>(lds, g, S, E, wave); }
    }
    GRID_BAR(5);
    if (IN(6)) { p6_cross(lds, wave); }
    GRID_BAR(6);
    if (IN(7)) {
        pg8::Gemm g{(const pbf*)(ws + WS_OM), (const pbf*)(ws + WS_WTO), MROWS, DM, MEMW}; pg8::StaticOrder S; S.init(MROWS, DM, G, bx);
        pg8::EpiResid E{(const float*)(ws + WS_X1), ARG_OUT(), nullptr, (float*)(ws + WS_PART2), DM};
        pg8::gemm_phase<pg8::EpiResid, pg8::StaticOrder, false, true>(lds, g, S, E, wave);
    }
    GRID_BAR(7);
    if (IN(8)) { p8_final(wave); }
#undef IN
#undef GRID_BAR
#undef ws
}

extern "C" void kernel_launch(void* const* d_in, const int* in_sizes, int n_in, void* d_out, int out_size, void* d_ws, size_t ws_size, hipStream_t stream) {
    static int grid = 0;
    if (grid == 0) {
        if (n_in != 16 || out_size != MROWS * DM || ws_size < WS_END) { fprintf(stderr, "kernel_launch: unexpected shapes (n_in %d out %d ws %zu)\n", n_in, out_size, ws_size); grid = -1; return; }
        int dev = 0, cus = 0, per_cu = 0;
        if (hipGetDevice(&dev) != hipSuccess || hipDeviceGetAttribute(&cus, hipDeviceAttributeMultiprocessorCount, dev) != hipSuccess) { grid = -1; return; }
        if (hipFuncSetAttribute((const void*)mega_fwd, hipFuncAttributeMaxDynamicSharedMemorySize, LDS_BYTES) != hipSuccess) { fprintf(stderr, "kernel_launch: hipFuncSetAttribute failed\n"); grid = -1; return; }
        if (hipOccupancyMaxActiveBlocksPerMultiprocessor(&per_cu, (const void*)mega_fwd, NWAVES * 64, LDS_BYTES) != hipSuccess || per_cu < 1) { fprintf(stderr, "kernel_launch: occupancy query says %d\n", per_cu); per_cu = 1; }
        (void)hipGetLastError();
        grid = cus;
    }
    if (grid < 0) return;
    (void)hipMemsetAsync((char*)d_ws + WS_CTL, 0, CTL_ZERO_BYTES, stream);
    Args a{};
    for (int i = 0; i < 16; ++i) a.in[i] = (const float*)d_in[i];
    a.out = (float*)d_out; a.ws = (unsigned char*)d_ws;
    if (N_LAUNCHES == 1) {
        a.ph_lo = 0; a.ph_hi = N_PHASES;
        void* args[] = {&a};
        hipError_t e = hipLaunchCooperativeKernel((const void*)mega_fwd, dim3(grid), dim3(NWAVES * 64), args, LDS_BYTES, stream);
        if (e != hipSuccess) fprintf(stderr, "kernel_launch: cooperative launch failed: %s (grid %d)\n", hipGetErrorString(e), grid);
    } else {
#ifndef PROBE_SEQ
#define PROBE_SEQ 0, 1, 2, 3, 4, 5, 6, 7, 8
#endif
        const int seq[] = {PROBE_SEQ};
        for (int i = 0; i < (int)(sizeof(seq) / sizeof(seq[0])); ++i) {
            const int p = seq[i];
            if (p == 3 && i > 0 && seq[i - 1] == 3) (void)hipMemsetAsync((char*)d_ws + WS_CTL, 0, CTL_ZERO_BYTES, stream);
            a.ph_lo = p; a.ph_hi = p + 1;
            hipLaunchKernelGGL(mega_fwd, dim3(grid), dim3(NWAVES * 64), LDS_BYTES, stream, a);
        }
    }
}
```
